# Optimizing an MI355X kernel written in HIP

```python
import jax
import jax.numpy as jnp
from jax import lax
import numpy as np


D_MODEL = 1024
BATCH = 8
SEQ = 4096
DEPTH = 2

GRID_W = 64
ROPE_THETA = 10000.0
NORM_EPS = 1e-6
NEG_INF = -1e30

MLA_HEADS = 4
MLA_NOPE = 128
MLA_ROPE = 64
MLA_V = 128
MLA_Q_RANK = 256
MLA_KV_RANK = 128
MLA_QBLOCK = 128
DIL_PATTERNS = ((128, 1), (512, 4), (2048, 16))
DIL_HEADS = 4
DIL_DH = 64
DIL_QBLOCK = 64
NAT_HEADS = 8
NAT_DH = 64
NAT_KH_MAX = 8
NAT_KW = 16
NAT_QCOL = 16
NAT_KCOL = NAT_QCOL + NAT_KW
GLA_HEADS = 4
GLA_DK = 64
GLA_DV = 128
GLA_GATE_RANK = 16
GLA_TAU = 16.0
GLA_CHUNK = 64

W_A = MLA_HEADS * MLA_V
W_B = DIL_HEADS * DIL_DH
W_C = NAT_HEADS * NAT_DH
W_D = GLA_HEADS * GLA_DV
N_BRANCH = 4

IN_SIZES = (MLA_Q_RANK, MLA_KV_RANK, MLA_ROPE,
            3 * len(DIL_PATTERNS) * W_B,
            W_C, W_C, W_C,
            GLA_HEADS * GLA_DK, GLA_HEADS * GLA_DK, W_D, GLA_GATE_RANK, GLA_GATE_RANK,
            W_A, W_B, W_C, W_D)
IN_SPLITS = tuple(int(s) for s in np.cumsum(IN_SIZES)[:-1])
D_IN = int(sum(IN_SIZES))

kernel_name = 'hybrid_gated_mla_dilated_nat_gla_encoder'


def rms_norm(x, g):
    xf = x.astype(jnp.float32)
    y = xf * lax.rsqrt(jnp.mean(xf * xf, axis=-1, keepdims=True) + NORM_EPS)
    return (y * g.astype(jnp.float32)).astype(x.dtype)


def rope(x, pos):
    dim = x.shape[-1]
    inv = jnp.power(ROPE_THETA, -jnp.arange(0, dim, 2, dtype=jnp.float32) / dim)
    ang = pos.astype(jnp.float32)[:, None] * inv[None, :]
    cos = jnp.cos(ang)[None, :, None, :]
    sin = jnp.sin(ang)[None, :, None, :]
    xf = x.astype(jnp.float32)
    x1, x2 = xf[..., :dim // 2], xf[..., dim // 2:]
    return jnp.concatenate([x1 * cos - x2 * sin, x2 * cos + x1 * sin], axis=-1).astype(x.dtype)


def mla_attention(q_lat, kv_lat, k_rope, q_norm_g, w_uq, kv_norm_g, w_ukv, pos):
    B_, S_, _ = q_lat.shape
    q = (rms_norm(q_lat, q_norm_g) @ w_uq).reshape(B_, S_, MLA_HEADS, MLA_NOPE + MLA_ROPE)
    q_nope, q_pe = q[..., :MLA_NOPE], rope(q[..., MLA_NOPE:], pos)
    kv = (rms_norm(kv_lat, kv_norm_g) @ w_ukv).reshape(B_, S_, MLA_HEADS, MLA_NOPE + MLA_V)
    k_nope, v = kv[..., :MLA_NOPE], kv[..., MLA_NOPE:]
    k_pe = rope(k_rope[:, :, None, :], pos)[:, :, 0]
    scale = (MLA_NOPE + MLA_ROPE) ** -0.5
    nqb = S_ // MLA_QBLOCK

    def blocks(t):
        return jnp.moveaxis(t.reshape(B_, nqb, MLA_QBLOCK, *t.shape[2:]), 1, 0)

    def attend(qb):
        qn, qr = qb
        s = jnp.einsum('bqhd,bkhd->bhqk', qn, k_nope) + jnp.einsum('bqhd,bkd->bhqk', qr, k_pe)
        p = jax.nn.softmax(s.astype(jnp.float32) * scale, axis=-1)
        return jnp.einsum('bhqk,bkhd->bqhd', p.astype(v.dtype), v)

    o = lax.map(attend, (blocks(q_nope), blocks(q_pe)))
    return jnp.moveaxis(o, 0, 1).reshape(B_, S_, W_A)


def dilated_group(q, k, v, window, dilation):
    B_, S_, H_, dh = q.shape
    r = dilation
    R = window // (2 * dilation)
    L = S_ // r
    QB = DIL_QBLOCK
    nb = -(-L // QB)
    Lp = nb * QB

    def to_sub(t):
        return t.reshape(B_, L, r, H_, dh).transpose(0, 2, 3, 1, 4)

    pad_q = ((0, 0), (0, 0), (0, 0), (0, Lp - L), (0, 0))
    pad_k = ((0, 0), (0, 0), (0, 0), (R, Lp - L + R), (0, 0))
    qs = jnp.pad(to_sub(q), pad_q)
    kp = jnp.pad(to_sub(k), pad_k)
    vp = jnp.pad(to_sub(v), pad_k)
    key_idx = np.arange(nb)[:, None] * QB + np.arange(QB + 2 * R)[None, :]
    kb = kp[:, :, :, key_idx]
    vb = vp[:, :, :, key_idx]
    qb = qs.reshape(B_, r, H_, nb, QB, dh)
    qpos = np.arange(nb)[:, None] * QB + np.arange(QB)[None, :]
    kpos = key_idx - R
    mask = ((np.abs(qpos[:, :, None] - kpos[:, None, :]) <= R)
            & (kpos[:, None, :] >= 0) & (kpos[:, None, :] < L))
    s = jnp.einsum('bmhnqd,bmhnkd->bmhnqk', qb, kb).astype(jnp.float32) * (dh ** -0.5)
    s = jnp.where(mask, s, NEG_INF)
    m = jnp.max(s, axis=-1, keepdims=True)
    p = jnp.exp(s - m)
    den = jnp.sum(p, axis=-1, keepdims=True)
    o = jnp.einsum('bmhnqk,bmhnkd->bmhnqd', p, vb.astype(jnp.float32)) / den
    lse = (m + jnp.log(den))[..., 0]
    o = o.reshape(B_, r, H_, Lp, dh)[:, :, :, :L].transpose(0, 3, 1, 2, 4).reshape(B_, S_, H_, dh)
    lse = lse.reshape(B_, r, H_, Lp)[..., :L].transpose(0, 3, 1, 2).reshape(B_, S_, H_)
    return o, lse


def dilated_attention(qkv, pos):
    B_, S_, _ = qkv.shape
    qkv = qkv.reshape(B_, S_, len(DIL_PATTERNS), 3, DIL_HEADS, DIL_DH)
    outs, lses = [], []
    for g, (window, dilation) in enumerate(DIL_PATTERNS):
        q = rope(qkv[:, :, g, 0], pos)
        k = rope(qkv[:, :, g, 1], pos)
        o, l = dilated_group(q, k, qkv[:, :, g, 2], window, dilation)
        outs.append(o)
        lses.append(l)
    w = jax.nn.softmax(jnp.stack(lses, axis=0), axis=0)
    o = jnp.sum(w[..., None] * jnp.stack(outs, axis=0), axis=0)
    return o.reshape(B_, S_, W_B).astype(qkv.dtype)


def neighbourhood_attention(q, k, v, rpb):
    B_, S_, _ = q.shape
    rows = S_ // GRID_W
    kh = min(NAT_KH_MAX, rows)

    def grid(t):
        return t.reshape(B_, rows, GRID_W, NAT_HEADS, NAT_DH).transpose(0, 3, 1, 2, 4)

    qg, kg, vg = grid(q), grid(k), grid(v)
    ncb = GRID_W // NAT_QCOL
    qcol = np.arange(GRID_W).reshape(ncb, NAT_QCOL)
    kcol_start = np.clip(np.arange(ncb) * NAT_QCOL - NAT_KW // 2, 0, GRID_W - NAT_KCOL)
    kcol = kcol_start[:, None] + np.arange(NAT_KCOL)[None, :]
    win_start = np.clip(qcol - NAT_KW // 2, 0, GRID_W - NAT_KW)
    col_mask = ((kcol[:, None, :] >= win_start[:, :, None])
                & (kcol[:, None, :] < win_start[:, :, None] + NAT_KW))
    col_off = np.clip(kcol[:, None, :] - qcol[:, :, None] + NAT_KW - 1, 0, 2 * NAT_KW - 2)
    rpb_cols = rpb[:, :, col_off]
    scale = NAT_DH ** -0.5

    def attend_row(r):
        rs = jnp.clip(r - kh // 2, 0, rows - kh)
        q_r = lax.dynamic_index_in_dim(qg, r, axis=2, keepdims=False)
        q_r = q_r.reshape(B_, NAT_HEADS, ncb, NAT_QCOL, NAT_DH)
        k_rows = lax.dynamic_slice_in_dim(kg, rs, kh, axis=2)[:, :, :, kcol]
        v_rows = lax.dynamic_slice_in_dim(vg, rs, kh, axis=2)[:, :, :, kcol]
        row_off = rs + jnp.arange(kh) - r + NAT_KH_MAX - 1
        bias = jnp.take(rpb_cols, row_off, axis=1).transpose(0, 2, 3, 1, 4)
        s = jnp.einsum('bhjqd,bhrjcd->bhjqrc', q_r, k_rows).astype(jnp.float32) * scale
        s = s + bias.astype(jnp.float32)[None]
        s = jnp.where(col_mask[None, None, :, :, None, :], s, NEG_INF)
        shp = s.shape
        p = jax.nn.softmax(s.reshape(*shp[:4], kh * NAT_KCOL), axis=-1).reshape(shp)
        o = jnp.einsum('bhjqrc,bhrjcd->bhjqd', p.astype(v_rows.dtype), v_rows)
        return o.reshape(B_, NAT_HEADS, GRID_W, NAT_DH)

    o = lax.map(attend_row, jnp.arange(rows))
    return o.transpose(1, 0, 3, 2, 4).reshape(B_, S_, W_C)


def gla_direction(q, k, v, log_a):
    B_, S_, H_, dk = q.shape
    dv = v.shape[-1]
    C = GLA_CHUNK
    n = S_ // C

    def ch(t):
        return t.reshape(B_, n, C, H_, t.shape[-1])

    q, k, v, log_a = ch(q), ch(k), ch(v), ch(log_a)
    b = jnp.cumsum(log_a, axis=2)
    b_last = b[:, :, -1]
    b_mid = b[:, :, C // 2 - 1][:, :, None]
    lower = np.tril(np.ones((C, C), dtype=bool))
    att = jnp.einsum('bnihd,bnjhd->bnhij', q * jnp.exp(b - b_mid), k * jnp.exp(b_mid - b))
    att = jnp.where(lower, att, 0.0)
    o = jnp.einsum('bnhij,bnjhe->bnihe', att, v)
    kv = jnp.einsum('bnjhd,bnjhe->bnhde', k * jnp.exp(b_last[:, :, None] - b), v)

    def step(state, inp):
        decay, kv_c = inp
        return decay[..., None] * state + kv_c, state

    _, states = lax.scan(step, jnp.zeros((B_, H_, dk, dv), jnp.float32),
                         (jnp.moveaxis(jnp.exp(b_last), 1, 0), jnp.moveaxis(kv, 1, 0)))
    o = o + jnp.einsum('bnihd,nbhde->bnihe', q * jnp.exp(b), states)
    return o.reshape(B_, S_, H_, dv)


def gla_attention(q, k, v, g_f, g_b, w_gf, b_gf, w_gb, b_gb, norm_g):
    B_, S_, _ = q.shape

    def heads(t, d):
        return t.astype(jnp.float32).reshape(B_, S_, GLA_HEADS, d)

    qh = heads(q, GLA_DK) * (GLA_DK ** -0.5)
    kh = heads(k, GLA_DK)
    vh = heads(v, GLA_DV)
    la_f = heads(jax.nn.log_sigmoid((g_f @ w_gf + b_gf).astype(jnp.float32)) / GLA_TAU, GLA_DK)
    la_b = heads(jax.nn.log_sigmoid((g_b @ w_gb + b_gb).astype(jnp.float32)) / GLA_TAU, GLA_DK)

    def flip(t):
        return jnp.flip(t, axis=1)

    o = gla_direction(qh, kh, vh, la_f) + flip(gla_direction(flip(qh), flip(kh), flip(vh), flip(la_b)))
    o = rms_norm(o, norm_g)
    return o.reshape(B_, S_, W_D).astype(q.dtype)


def hybrid_layer(x, pos, norm_g, w_in, q_norm_g, w_uq, kv_norm_g, w_ukv, rpb,
                 w_gf, b_gf, w_gb, b_gb, gla_norm_g, w_pa, w_pb, w_pc, w_pd,
                 w_merge, b_merge, w_out):
    B_, S_, _ = x.shape
    h = rms_norm(x, norm_g)
    (a_q, a_kv, a_kr, b_qkv, c_q, c_k, c_v, d_q, d_k, d_v, d_gf, d_gb,
     z_a, z_b, z_c, z_d) = jnp.split(h @ w_in, IN_SPLITS, axis=-1)
    o_a = mla_attention(a_q, a_kv, a_kr, q_norm_g, w_uq, kv_norm_g, w_ukv, pos) * jax.nn.silu(z_a)
    o_b = dilated_attention(b_qkv, pos) * jax.nn.silu(z_b)
    o_c = neighbourhood_attention(c_q, c_k, c_v, rpb) * jax.nn.silu(z_c)
    o_d = gla_attention(d_q, d_k, d_v, d_gf, d_gb, w_gf, b_gf, w_gb, b_gb, gla_norm_g) * jax.nn.silu(z_d)
    gates = jax.nn.sigmoid((h @ w_merge + b_merge).astype(jnp.float32)).astype(x.dtype)
    gates = gates.reshape(B_, S_, N_BRANCH, x.shape[-1])
    mixed = (gates[:, :, 0] * (o_a @ w_pa) + gates[:, :, 1] * (o_b @ w_pb)
             + gates[:, :, 2] * (o_c @ w_pc) + gates[:, :, 3] * (o_d @ w_pd))
    return x + mixed @ w_out


def setup_inputs(seed: int = 0) -> dict:
    key = jax.random.key(seed)
    ks = jax.random.split(key, 21)

    def nrm(k, shape, scale):
        return jax.random.normal(k, shape, jnp.float32) * scale

    def gain(k, shape):
        return 1.0 + 0.02 * jax.random.normal(k, shape, jnp.float32)

    L_, D = DEPTH, D_MODEL
    return {
        'x': nrm(ks[0], (BATCH, SEQ, D), 1.0),
        'norm_g': gain(ks[1], (L_, D)),
        'w_in': nrm(ks[2], (L_, D, D_IN), D ** -0.5),
        'mla_q_norm_g': gain(ks[3], (L_, MLA_Q_RANK)),
        'mla_w_uq': nrm(ks[4], (L_, MLA_Q_RANK, MLA_HEADS * (MLA_NOPE + MLA_ROPE)), MLA_Q_RANK ** -0.5),
        'mla_kv_norm_g': gain(ks[5], (L_, MLA_KV_RANK)),
        'mla_w_ukv': nrm(ks[6], (L_, MLA_KV_RANK, MLA_HEADS * (MLA_NOPE + MLA_V)), MLA_KV_RANK ** -0.5),
        'nat_rpb': nrm(ks[7], (L_, NAT_HEADS, 2 * NAT_KH_MAX - 1, 2 * NAT_KW - 1), 0.1),
        'gla_w_gate_f': nrm(ks[8], (L_, GLA_GATE_RANK, GLA_HEADS * GLA_DK), GLA_GATE_RANK ** -0.5),
        'gla_b_gate_f': nrm(ks[9], (L_, GLA_HEADS * GLA_DK), 0.1),
        'gla_w_gate_b': nrm(ks[10], (L_, GLA_GATE_RANK, GLA_HEADS * GLA_DK), GLA_GATE_RANK ** -0.5),
        'gla_b_gate_b': nrm(ks[11], (L_, GLA_HEADS * GLA_DK), 0.1),
        'gla_norm_g': gain(ks[12], (L_, GLA_HEADS, GLA_DV)),
        'w_proj_a': nrm(ks[13], (L_, W_A, D), W_A ** -0.5),
        'w_proj_b': nrm(ks[14], (L_, W_B, D), W_B ** -0.5),
        'w_proj_c': nrm(ks[15], (L_, W_C, D), W_C ** -0.5),
        'w_proj_d': nrm(ks[16], (L_, W_D, D), W_D ** -0.5),
        'w_merge': nrm(ks[17], (L_, D, N_BRANCH * D), D ** -0.5),
        'b_merge': nrm(ks[18], (L_, N_BRANCH * D), 0.02),
        'w_out': nrm(ks[19], (L_, D, D), D ** -0.5),
        'final_norm_g': gain(ks[20], (D,)),
    }


def reference(x, norm_g, w_in, mla_q_norm_g, mla_w_uq, mla_kv_norm_g, mla_w_ukv, nat_rpb,
              gla_w_gate_f, gla_b_gate_f, gla_w_gate_b, gla_b_gate_b, gla_norm_g,
              w_proj_a, w_proj_b, w_proj_c, w_proj_d, w_merge, b_merge, w_out, final_norm_g):
    pos = jnp.arange(x.shape[1], dtype=jnp.int32)
    for l in range(DEPTH):
        x = hybrid_layer(x, pos, norm_g[l], w_in[l], mla_q_norm_g[l], mla_w_uq[l],
                         mla_kv_norm_g[l], mla_w_ukv[l], nat_rpb[l],
                         gla_w_gate_f[l], gla_b_gate_f[l], gla_w_gate_b[l], gla_b_gate_b[l],
                         gla_norm_g[l], w_proj_a[l], w_proj_b[l], w_proj_c[l], w_proj_d[l],
                         w_merge[l], b_merge[l], w_out[l])
    return rms_norm(x, final_norm_g)
```

```cpp
#include <hip/hip_runtime.h>
#include <hip/hip_cooperative_groups.h>
#include <cstdio>
#include <cstdint>
namespace cg = cooperative_groups;

#define LAS __attribute__((address_space(3)))
#define DI __device__ __forceinline__
typedef unsigned short bf16_t;
typedef short bf16x8 __attribute__((ext_vector_type(8)));
typedef short s16x4 __attribute__((ext_vector_type(4)));
typedef float f32x4 __attribute__((ext_vector_type(4)));
typedef unsigned u32x4 __attribute__((ext_vector_type(4)));
typedef unsigned u32x2 __attribute__((ext_vector_type(2)));
typedef _Float16 h16x8 __attribute__((ext_vector_type(8)));
typedef float f32x8 __attribute__((ext_vector_type(8)));

constexpr int SEQ = 4096, DM = 1024, TG = 16384, NGRP = 2, DIN = 7136;
constexpr float EPS = 1e-6f, LOG2E = 1.4426950408889634f, LN2 = 0.6931471805599453f;
constexpr float QSCALE = 0.07216878364870322f * 1.4426950408889634f;
constexpr int NPH = 26;

constexpr size_t MiB = 1u << 20;
constexpr size_t WS_ROPEC = 0, WS_ROPES = MiB / 2;
constexpr size_t WS_SSQ = 1 * MiB, WS_LSE = 1 * MiB + 256 * 1024;
constexpr size_t WS_DEC = 2 * MiB, WS_GFB = 3 * MiB, WS_BAR = 5 * MiB;
constexpr size_t WS_W = 6 * MiB, W_LSTRIDE = 30 * MiB;
constexpr size_t W_1T = 0, W_GT = 14 * MiB, W_UP = 22 * MiB, W_PA = 24 * MiB, W_PB = 25 * MiB, W_PC = 25 * MiB + MiB / 2, W_PD = 26 * MiB + MiB / 2, W_OUT = 27 * MiB + MiB / 2;
constexpr size_t WS_H = 66 * MiB, WS_LAT = 98 * MiB, WS_Z = 110 * MiB;
constexpr size_t WS_OA = 166 * MiB, WS_OB = 182 * MiB, WS_OC = 190 * MiB, WS_OD = 206 * MiB;
constexpr size_t WS_BQKV = 222 * MiB, WS_MIXED = 222 * MiB;
constexpr size_t WS_CQ = 294 * MiB, WS_CK = 310 * MiB, WS_CV = 326 * MiB;
constexpr size_t WS_SCRG = 294 * MiB, WS_MIXACC = 326 * MiB;
constexpr size_t WS_DQ = 342 * MiB, WS_DK = 350 * MiB, WS_DV = 358 * MiB;
constexpr size_t WS_MQ = 374 * MiB, WS_MK = 398 * MiB, WS_MV = 422 * MiB;
constexpr size_t WS_KV = 438 * MiB, WS_OBG = 470 * MiB, WS_LAC = 494 * MiB, WS_END = 510 * MiB;
constexpr int LDS_BYTES = 131072 + 256 + 3840;
static_assert(WS_OB == WS_OA + 16 * MiB && WS_OC == WS_OA + 24 * MiB && WS_OD == WS_OA + 40 * MiB, "O map");
static_assert(W_PB == W_PA + MiB && W_PC == W_PA + MiB + MiB / 2 && W_PD == W_PA + 2 * MiB + MiB / 2, "Wp map");

typedef float f32x2 __attribute__((ext_vector_type(2)));
typedef __bf16 bf16x2_t __attribute__((ext_vector_type(2)));
DI unsigned cvt_pk_bf16(float lo, float hi) { const f32x2 f = {lo, hi}; const bf16x2_t v = __builtin_convertvector(f, bf16x2_t); return __builtin_bit_cast(unsigned, v); }
DI float bf2f(unsigned short h) { return __uint_as_float(((unsigned)h) << 16); }
DI float bflo(unsigned w) { return __uint_as_float(w << 16); }
DI float bfhi(unsigned w) { return __uint_as_float(w & 0xffff0000u); }
DI f32x4 mfma16(bf16x8 a, bf16x8 b, f32x4 c) { return __builtin_amdgcn_mfma_f32_16x16x32_bf16(a, b, c, 0, 0, 0); }
DI s16x4 trread(LAS unsigned char* p) { return __builtin_amdgcn_ds_read_tr16_b64_v4i16((LAS s16x4*)p); }
DI bf16x8 cat8(s16x4 lo, s16x4 hi) { return __builtin_shufflevector(lo, hi, 0, 1, 2, 3, 4, 5, 6, 7); }
DI bf16x8 pack8(f32x4 a, f32x4 b) { u32x4 w; w.x = cvt_pk_bf16(a[0], a[1]); w.y = cvt_pk_bf16(a[2], a[3]); w.z = cvt_pk_bf16(b[0], b[1]); w.w = cvt_pk_bf16(b[2], b[3]); return __builtin_bit_cast(bf16x8, w); }
DI float ex2(float x) { return __builtin_amdgcn_exp2f(x); }
DI float siluf(float x) { return x * __builtin_amdgcn_rcpf(1.0f + __builtin_amdgcn_exp2f(-1.4426950408889634f * x)); }
DI float sigmf(float x) { return __builtin_amdgcn_rcpf(1.0f + __builtin_amdgcn_exp2f(-1.4426950408889634f * x)); }
DI float shx(float v, int mask, int lane) { return __int_as_float(__builtin_amdgcn_ds_bpermute((lane ^ mask) << 2, __float_as_int(v))); }
DI float wave_sum(float v, int lane) {
#pragma unroll
    for (int o = 1; o < 64; o <<= 1) v += shx(v, o, lane);
    return v;
}
DI int clampi(int v, int lo, int hi) { return v < lo ? lo : (v > hi ? hi : v); }
DI int perm32(int p) { return 8 * ((p >> 2) & 3) + 4 * ((p >> 4) & 1) + (p & 3); }
DI int pcol(int c) { return (c & ~31) | perm32(c & 31); }
DI int rope_perm(int p) { return 32 * ((p >> 4) & 1) + 16 * ((p >> 5) & 1) + (p & 15); }

namespace pg8 {
constexpr int BM = 256, BK = 64, HALF = 128, HTB = HALF * BK * 2, NXCD = 8, WGM = 8;
DI int lds_byte(int r, int c) { const int st = (r >> 4) * 2 + (c >> 5), rr = r & 15, cc = c & 31, ob = rr * 64 + cc * 2; return st * 1024 + (ob ^ (((ob >> 9) & 1) << 5)); }
DI void stage_rc(int b, int& R, int& C) { const int st = b / 1024, sb = b % 1024, swz = sb ^ (((sb >> 9) & 1) << 5); R = (st >> 1) * 16 + swz / 64; C = (st & 1) * 32 + (swz % 64) / 2; }

struct Unit { const char* A; const char* B; int K; int pm, pn, tag; };

struct NoState {};
template <class Epi, class Sched, class State = NoState>
DI void gemm_phase(LAS unsigned char* lds, const Sched& S, const Epi& E, int tid) {
    State est;
    const int wid = __builtin_amdgcn_readfirstlane(tid >> 6), lane = tid & 63, wr = wid >> 2, wc = wid & 3, fr = lane & 15, fq = lane >> 4;
    int R0, C0; stage_rc(tid * 16, R0, C0);
    const size_t kstep = (size_t)(BK * 2);
    const unsigned ldsw = (unsigned)wid * 1024u;
    const int aoff = lds_byte(wr * 64 + fr, fq * 8), boff = lds_byte(wc * 32 + fr, fq * 8);
#define PG8_SA(b, h) (((b) * 2 + (h)) * HTB)
#define PG8_SB(b, h) ((4 + (b) * 2 + (h)) * HTB)
#define PG8_STAGE(bufoff, gbase, v0, qs) do { \
        __builtin_amdgcn_global_load_lds((const unsigned*)((const char*)(gbase) + (v0)), (LAS unsigned*)(lds + (bufoff) + ldsw), 16, 0, 0); \
        __builtin_amdgcn_global_load_lds((const unsigned*)((const char*)(gbase) + (qs) + (v0)), (LAS unsigned*)(lds + (bufoff) + ldsw + 8192), 16, 0, 0); } while (0)
#define PG8_LDA(dst, b, h) do { _Pragma("unroll") for (int m = 0; m < 4; ++m) _Pragma("unroll") for (int k = 0; k < 2; ++k) dst[m][k] = *(const LAS bf16x8*)(lds + PG8_SA(b, h) + aoff + m * 2048 + k * 1024); } while (0)
#define PG8_LDB(dst, b, h) do { _Pragma("unroll") for (int n = 0; n < 2; ++n) _Pragma("unroll") for (int k = 0; k < 2; ++k) dst[n][k] = *(const LAS bf16x8*)(lds + PG8_SB(b, h) + boff + n * 2048 + k * 1024); } while (0)
#define PG8_MMA(ai, bj, At, Bt) do { __builtin_amdgcn_s_setprio(1); _Pragma("unroll") for (int m = 0; m < 4; ++m) _Pragma("unroll") for (int n = 0; n < 2; ++n) _Pragma("unroll") for (int k = 0; k < 2; ++k) \
        acc[ai][bj][m][n] = __builtin_amdgcn_mfma_f32_16x16x32_bf16(Bt[n][k], At[m][k], acc[ai][bj][m][n], 0, 0, 0); __builtin_amdgcn_s_setprio(0); } while (0)
#define PG8_WAIT_V(n) asm volatile("s_waitcnt vmcnt(" #n ")" ::: "memory")
#define PG8_WAIT_L(n) asm volatile("s_waitcnt lgkmcnt(" #n ")" ::: "memory")
#define PG8_BAR __builtin_amdgcn_s_barrier()
#define PG8_SCHED __builtin_amdgcn_sched_barrier(0)
    Unit cur, nxt; int ui = 0;
    if (!S.next(0, cur)) return;
    f32x4 acc[2][2][4][2];
#pragma unroll
    for (int a = 0; a < 2; ++a)
#pragma unroll
        for (int b = 0; b < 2; ++b)
#pragma unroll
            for (int m = 0; m < 4; ++m)
#pragma unroll
                for (int n = 0; n < 2; ++n) acc[a][b][m][n] = (f32x4){0.f, 0.f, 0.f, 0.f};
    bf16x8 At[4][2], B0[2][2], B1[2][2];
    const char* cA = cur.A; const char* cB = cur.B; int cK = cur.K;
    unsigned cv0 = (unsigned)(R0 * cK + C0) * 2u; size_t chs = (size_t)HALF * cK * 2, cv1 = chs >> 1;
    PG8_STAGE(PG8_SB(0, 0), cB, cv0, cv1); PG8_STAGE(PG8_SB(0, 1), cB + chs, cv0, cv1); PG8_STAGE(PG8_SA(0, 0), cA, cv0, cv1); PG8_STAGE(PG8_SA(0, 1), cA + chs, cv0, cv1);
    if (wr == 1) PG8_BAR;
    PG8_WAIT_V(2); PG8_BAR;
    PG8_STAGE(PG8_SB(1, 0), cB + kstep, cv0, cv1); PG8_STAGE(PG8_SA(1, 0), cA + kstep, cv0, cv1); PG8_STAGE(PG8_SB(1, 1), cB + chs + kstep, cv0, cv1);
    PG8_WAIT_V(6); PG8_BAR;
    for (;;) {
        const bool has_next = S.next(ui + 1, nxt);
        const char* nA = has_next ? nxt.A : cA; const char* nB = has_next ? nxt.B : cB; const int nK = has_next ? nxt.K : cK;
        unsigned nv0; { int t2 = tid; asm volatile("" : "+v"(t2)); int R2, C2; stage_rc(t2 * 16, R2, C2); nv0 = (unsigned)(R2 * nK + C2) * 2u; }
        const size_t nhs = (size_t)HALF * nK * 2, nv1 = nhs >> 1;
        const int nt = cK / BK;
        for (int t = 0; t < nt; t += 2) {
            const bool last = (t == nt - 2);
            const char* a1 = cA + (size_t)(t + 1) * kstep;
            const char* a2 = last ? nA : cA + (size_t)(t + 2) * kstep; const char* b2 = last ? nB : cB + (size_t)(t + 2) * kstep;
            const char* a3 = a2 + kstep; const char* b3 = b2 + kstep;
            const unsigned w0 = last ? nv0 : cv0; const size_t hs2 = last ? nhs : chs, w1 = hs2 >> 1;
            PG8_LDB(B0, 0, 0); PG8_LDB(B1, 0, 1); PG8_SCHED; PG8_LDA(At, 0, 0); PG8_STAGE(PG8_SA(1, 1), a1 + chs, cv0, cv1);
            PG8_WAIT_V(8); PG8_WAIT_L(0); PG8_BAR; PG8_MMA(0, 0, At, B0); PG8_MMA(0, 1, At, B1); PG8_BAR; PG8_SCHED;
            PG8_LDA(At, 0, 1); PG8_STAGE(PG8_SB(0, 0), b2, w0, w1); PG8_STAGE(PG8_SB(0, 1), b2 + hs2, w0, w1); PG8_STAGE(PG8_SA(0, 0), a2, w0, w1);
            PG8_WAIT_V(8); PG8_WAIT_L(0); PG8_BAR; PG8_MMA(1, 0, At, B0); PG8_MMA(1, 1, At, B1); PG8_BAR; PG8_SCHED;
            PG8_LDB(B0, 1, 0); PG8_LDB(B1, 1, 1); PG8_SCHED; PG8_LDA(At, 1, 0); PG8_STAGE(PG8_SA(0, 1), a2 + hs2, w0, w1);
            PG8_WAIT_V(8); PG8_WAIT_L(0); PG8_BAR; PG8_MMA(0, 0, At, B0); PG8_MMA(0, 1, At, B1); PG8_BAR; PG8_SCHED;
            PG8_LDA(At, 1, 1); PG8_STAGE(PG8_SB(1, 0), b3, w0, w1); PG8_STAGE(PG8_SB(1, 1), b3 + hs2, w0, w1); PG8_STAGE(PG8_SA(1, 0), a3, w0, w1);
            PG8_WAIT_V(8); PG8_WAIT_L(0); PG8_BAR; PG8_MMA(1, 0, At, B0); PG8_MMA(1, 1, At, B1); PG8_BAR; PG8_SCHED;
        }
        if (wr == 0) PG8_BAR;
        { int efr = fr, efq = fq; asm volatile("" : "+v"(efr), "+v"(efq)); E(acc, cur, wr, wc, efr, efq, est); }
        if (!has_next) break;
#pragma unroll
        for (int a = 0; a < 2; ++a)
#pragma unroll
            for (int b = 0; b < 2; ++b)
#pragma unroll
                for (int m = 0; m < 4; ++m)
#pragma unroll
                    for (int n = 0; n < 2; ++n) acc[a][b][m][n] = (f32x4){0.f, 0.f, 0.f, 0.f};
        cur = nxt; cA = nA; cB = nB; cK = nK; cv0 = nv0; cv1 = nv1; chs = nhs; ++ui;
        if (wr == 1) PG8_BAR;
    }
    PG8_WAIT_V(0);
    PG8_BAR;
#undef PG8_SA
#undef PG8_SB
#undef PG8_STAGE
#undef PG8_LDA
#undef PG8_LDB
#undef PG8_MMA
#undef PG8_WAIT_V
#undef PG8_WAIT_L
#undef PG8_BAR
#undef PG8_SCHED
}

struct SchedStd {
    const char* A; const char* B; int K, nM, nN, nwg, G, c, rep;
    DI void init(const void* A_, const void* B_, int M, int N, int K_, int G_, int c_, int rep_ = 1) { A = (const char*)A_; B = (const char*)B_; K = K_; nM = M / BM; nN = N / BM; nwg = nM * nN; G = G_; c = c_; rep = rep_; }
    DI bool next(int i, Unit& u) const {
        const long L0 = (long)i * G + c; if (L0 >= (long)nwg * rep) return false;
        int wgid = (int)(L0 % nwg); const int tg = (L0 >= nwg) ? 1 : 0; { const int q = nwg / NXCD, r = nwg % NXCD, xcd = wgid % NXCD, off = wgid / NXCD; wgid = (xcd < r ? xcd * (q + 1) : r * (q + 1) + (xcd - r) * q) + off; }
        const int nig = WGM * nN, gid = wgid / nig, fm = gid * WGM, gsz = (nM - fm) < WGM ? (nM - fm) : WGM;
        u.pm = fm + ((wgid % nig) % gsz); u.pn = (wgid % nig) / gsz; u.K = K; u.tag = tg;
        u.A = A + (size_t)u.pm * BM * K * 2; u.B = B + (size_t)u.pn * BM * K * 2; return true;
    }
};
struct SchedUp {
    const char* ws; const char* wb; int G, c, rep;
    DI bool next(int i, Unit& u) const {
        const int nwg = 448; const long L0 = (long)i * G + c; if (L0 >= (long)nwg * rep) return false;
        int wgid = (int)(L0 % nwg); u.tag = (L0 >= nwg) ? 1 : 0;
        { const int q = nwg / NXCD, xcd = wgid % NXCD, off = wgid / NXCD; wgid = xcd * q + off; }
        const int nig = WGM * 7, gid = wgid / nig, fm = gid * WGM;
        u.pm = fm + ((wgid % nig) % WGM); u.pn = (wgid % nig) / WGM;
        if (u.pn < 3) { u.K = 256; u.A = ws + WS_LAT + (size_t)u.pm * BM * 256 * 2; u.B = wb + W_UP + (size_t)u.pn * BM * 256 * 2; }
        else { u.K = 128; u.A = ws + WS_LAT + (size_t)TG * 256 * 2 + (size_t)u.pm * BM * 128 * 2; u.B = wb + W_UP + 768 * 256 * 2 + (size_t)(u.pn - 3) * BM * 128 * 2; }
        return true;
    }
};
struct SchedMix {
    const char* ws; const char* wb; int G, c, rep;
    DI bool next(int i, Unit& u) const {
        int tile = (i >> 3) * G + c; if (tile >= 256 * rep) return false; tile &= 255;
        const int sub = i & 7, j = sub >> 1; u.pm = (tile & 7) * 8 + (tile >> 5); u.pn = (tile >> 3) & 3; u.tag = sub;
        if ((sub & 1) == 0) { u.K = 1024; u.A = ws + WS_H + (size_t)u.pm * BM * 1024 * 2; u.B = wb + W_GT + (size_t)(j * 1024 + u.pn * BM) * 1024 * 2; }
        else { const int Kj = (j == 1) ? 256 : 512;
            const size_t ao = WS_OA + (size_t)j * (16 * MiB) - (j >= 2 ? 8 * MiB : 0);
            const size_t bo = W_PA + (size_t)j * MiB - (j >= 2 ? MiB / 2 : 0);
            u.K = Kj; u.A = ws + ao + (size_t)u.pm * BM * Kj * 2; u.B = wb + bo + (size_t)u.pn * BM * Kj * 2; }
        return true;
    }
};
}
using pg8::Unit;

template <int ACT>
DI void store_plain(const f32x4 (&acc)[2][2][4][2], bf16_t* dst, int ld, float scale, int row0, int wc, int fq) {
#pragma unroll
    for (int ai = 0; ai < 2; ++ai)
#pragma unroll
        for (int m = 0; m < 4; ++m) {
            bf16_t* rowp = dst + (size_t)(row0 + ai * 128 + m * 16) * ld + wc * 32 + 8 * fq;
#pragma unroll
            for (int bj = 0; bj < 2; ++bj) {
                f32x4 v0 = acc[ai][bj][m][0] * scale, v1 = acc[ai][bj][m][1] * scale;
                if (ACT == 1) { v0[0] = siluf(v0[0]); v0[1] = siluf(v0[1]); v0[2] = siluf(v0[2]); v0[3] = siluf(v0[3]); v1[0] = siluf(v1[0]); v1[1] = siluf(v1[1]); v1[2] = siluf(v1[2]); v1[3] = siluf(v1[3]); }
                u32x4 w; w.x = cvt_pk_bf16(v0[0], v0[1]); w.y = cvt_pk_bf16(v0[2], v0[3]); w.z = cvt_pk_bf16(v1[0], v1[1]); w.w = cvt_pk_bf16(v1[2], v1[3]);
                *(u32x4*)(rowp + bj * 128) = w;
            }
        }
}
DI void store_rope(const f32x4 (&acc)[2][2][4][2], bf16_t* dst, int ld, int hstride, float scale, const float* rc, const float* rs, int row0, int wc, int fq) {
    const int i0 = 16 * (wc & 1) + 4 * fq;
#pragma unroll
    for (int ai = 0; ai < 2; ++ai)
#pragma unroll
        for (int m = 0; m < 4; ++m) {
            const int row = row0 + ai * 128 + m * 16, pos = row & (SEQ - 1);
            const f32x4 c = *(const f32x4*)(rc + pos * 32 + i0), s = *(const f32x4*)(rs + pos * 32 + i0);
#pragma unroll
            for (int bj = 0; bj < 2; ++bj) {
                const int head = 2 * bj + (wc >> 1);
                const f32x4 x1 = acc[ai][bj][m][0] * scale, x2 = acc[ai][bj][m][1] * scale;
                const f32x4 o1 = x1 * c - x2 * s, o2 = x2 * c + x1 * s;
                bf16_t* p = dst + (size_t)row * ld + head * hstride + i0;
                u32x2 w; w.x = cvt_pk_bf16(o1[0], o1[1]); w.y = cvt_pk_bf16(o1[2], o1[3]); *(u32x2*)p = w;
                w.x = cvt_pk_bf16(o2[0], o2[1]); w.y = cvt_pk_bf16(o2[2], o2[3]); *(u32x2*)(p + 32) = w;
            }
        }
}

struct EpiIn {
    unsigned char* ws;
    template <class St> DI void operator()(const f32x4 (&acc)[2][2][4][2], const Unit& u, int wr, int wc, int fr, int fq, St& est) const {
        bf16_t* const LAT = (bf16_t*)(ws + WS_LAT); bf16_t* const MK = (bf16_t*)(ws + WS_MK); bf16_t* const BQKV = (bf16_t*)(ws + WS_BQKV);
        bf16_t* const CQ = (bf16_t*)(ws + WS_CQ); bf16_t* const CK = (bf16_t*)(ws + WS_CK); bf16_t* const CV = (bf16_t*)(ws + WS_CV);
        bf16_t* const DQ = (bf16_t*)(ws + WS_DQ); bf16_t* const DK = (bf16_t*)(ws + WS_DK); bf16_t* const DV = (bf16_t*)(ws + WS_DV); bf16_t* const Z = (bf16_t*)(ws + WS_Z);
        float* const GFB = (float*)(ws + WS_GFB); float* const SSQ = (float*)(ws + WS_SSQ); const float* const rc = (const float*)(ws + WS_ROPEC); const float* const rs = (const float*)(ws + WS_ROPES);
        const int pn = u.pn, row0 = u.pm * 256 + wr * 64 + fr, lane = fq * 16 + fr;
        if (pn == 0) {
            store_plain<0>(acc, LAT, 256, 1.f, row0, wc, fq);
#pragma unroll
            for (int ai = 0; ai < 2; ++ai)
#pragma unroll
                for (int m = 0; m < 4; ++m) {
                    float s = 0.f;
#pragma unroll
                    for (int bj = 0; bj < 2; ++bj)
#pragma unroll
                        for (int n = 0; n < 2; ++n) { const f32x4 v = acc[ai][bj][m][n]; s += v[0] * v[0] + v[1] * v[1] + v[2] * v[2] + v[3] * v[3]; }
                    s += shx(s, 16, lane); s += shx(s, 32, lane);
                    if (fq == 0 && u.tag == 0) atomicAdd(SSQ + (size_t)(row0 + ai * 128 + m * 16) * 2, s);
                }
        } else if (pn == 1) {
#pragma unroll
            for (int ai = 0; ai < 2; ++ai)
#pragma unroll
                for (int m = 0; m < 4; ++m) {
                    const int row = row0 + ai * 128 + m * 16;
                    float s = 0.f;
#pragma unroll
                    for (int n = 0; n < 2; ++n) { const f32x4 v = acc[ai][0][m][n]; s += v[0] * v[0] + v[1] * v[1] + v[2] * v[2] + v[3] * v[3]; }
                    { const f32x4 v0 = acc[ai][0][m][0], v1 = acc[ai][0][m][1]; u32x4 w; w.x = cvt_pk_bf16(v0[0], v0[1]); w.y = cvt_pk_bf16(v0[2], v0[3]); w.z = cvt_pk_bf16(v1[0], v1[1]); w.w = cvt_pk_bf16(v1[2], v1[3]);
                      *(u32x4*)(LAT + (size_t)TG * 256 + (size_t)row * 128 + wc * 32 + 8 * fq) = w; }
                    s += shx(s, 16, lane); s += shx(s, 32, lane);
                    if (fq == 0 && u.tag == 0) atomicAdd(SSQ + (size_t)row * 2 + 1, s);
                    if (wc < 2) {
                        const int i0 = 16 * wc + 4 * fq, pos = row & (SEQ - 1);
                        const f32x4 c = *(const f32x4*)(rc + pos * 32 + i0), sn = *(const f32x4*)(rs + pos * 32 + i0);
                        const f32x4 x1 = acc[ai][1][m][0], x2 = acc[ai][1][m][1];
                        const f32x4 o1 = x1 * c - x2 * sn, o2 = x2 * c + x1 * sn;
                        u32x2 w1, w2; w1.x = cvt_pk_bf16(o1[0], o1[1]); w1.y = cvt_pk_bf16(o1[2], o1[3]); w2.x = cvt_pk_bf16(o2[0], o2[1]); w2.y = cvt_pk_bf16(o2[2], o2[3]);
#pragma unroll
                        for (int hh = 0; hh < 4; ++hh) { bf16_t* p = MK + (size_t)row * 768 + hh * 192 + 128 + i0; *(u32x2*)p = w1; *(u32x2*)(p + 32) = w2; }
                    } else if (wc == 2) {
#pragma unroll
                        for (int n = 0; n < 2; ++n) *(f32x4*)(GFB + (size_t)row * 32 + n * 16 + 4 * fq) = acc[ai][1][m][n];
                    }
                }
        } else if (pn <= 10) {
            const int s = pn - 2, which = s % 3; bf16_t* dst = BQKV + (size_t)s * TG * 256;
            if (which == 2) store_plain<0>(acc, dst, 256, 1.f, row0, wc, fq);
            else store_rope(acc, dst, 256, 64, which == 0 ? 0.125f : 1.f, rc, rs, row0, wc, fq);
        } else if (pn <= 16) {
            const int t = pn - 11, buf = t >> 1; bf16_t* dst = (buf == 0 ? CQ : (buf == 1 ? CK : CV)) + (t & 1) * 256;
            store_plain<0>(acc, dst, 512, buf == 0 ? 0.125f : 1.f, row0, wc, fq);
        } else if (pn == 17) store_plain<0>(acc, DQ, 256, 0.125f, row0, wc, fq);
        else if (pn == 18) store_plain<0>(acc, DK, 256, 1.f, row0, wc, fq);
        else if (pn <= 20) store_plain<0>(acc, DV + (pn - 19) * 256, 512, 1.f, row0, wc, fq);
        else store_plain<1>(acc, Z + (pn - 21) * 256, 1792, 1.f, row0, wc, fq);
    }
};

struct EpiUp {
    unsigned char* ws;
    template <class St> DI void operator()(const f32x4 (&acc)[2][2][4][2], const Unit& u, int wr, int wc, int fr, int fq, St& est) const {
        bf16_t* const MQ = (bf16_t*)(ws + WS_MQ); bf16_t* const MK = (bf16_t*)(ws + WS_MK); bf16_t* const MV = (bf16_t*)(ws + WS_MV);
        const float* const SSQ = (const float*)(ws + WS_SSQ); const float* const rc = (const float*)(ws + WS_ROPEC); const float* const rs = (const float*)(ws + WS_ROPES);
        const int pn = u.pn, row0 = u.pm * 256 + wr * 64 + fr;
#pragma unroll
        for (int ai = 0; ai < 2; ++ai)
#pragma unroll
            for (int m = 0; m < 4; ++m) {
                const int row = row0 + ai * 128 + m * 16;
                const float rsc = (pn < 3) ? rsqrtf(SSQ[(size_t)row * 2] * (1.f / 256.f) + EPS) * QSCALE : rsqrtf(SSQ[(size_t)row * 2 + 1] * (1.f / 128.f) + EPS);
                if (pn == 2) {
                    const int i0 = 16 * (wc & 1) + 4 * fq, pos = row & (SEQ - 1);
                    const f32x4 c = *(const f32x4*)(rc + pos * 32 + i0), sn = *(const f32x4*)(rs + pos * 32 + i0);
#pragma unroll
                    for (int bj = 0; bj < 2; ++bj) {
                        const int head = 2 * bj + (wc >> 1);
                        const f32x4 x1 = acc[ai][bj][m][0] * rsc, x2 = acc[ai][bj][m][1] * rsc;
                        const f32x4 o1 = x1 * c - x2 * sn, o2 = x2 * c + x1 * sn;
                        bf16_t* p = MQ + (size_t)row * 768 + head * 192 + 128 + i0;
                        u32x2 w; w.x = cvt_pk_bf16(o1[0], o1[1]); w.y = cvt_pk_bf16(o1[2], o1[3]); *(u32x2*)p = w;
                        w.x = cvt_pk_bf16(o2[0], o2[1]); w.y = cvt_pk_bf16(o2[2], o2[3]); *(u32x2*)(p + 32) = w;
                    }
                } else {
#pragma unroll
                    for (int bj = 0; bj < 2; ++bj) {
                        bf16_t* p;
                        if (pn < 2) p = MQ + (size_t)row * 768 + (2 * pn + bj) * 192;
                        else if (pn < 5) p = MK + (size_t)row * 768 + (2 * (pn - 3) + bj) * 192;
                        else p = MV + (size_t)row * 512 + (pn - 5) * 256 + bj * 128;
                        p += wc * 32 + 8 * fq;
                        { const f32x4 v0 = acc[ai][bj][m][0] * rsc, v1 = acc[ai][bj][m][1] * rsc; u32x4 w; w.x = cvt_pk_bf16(v0[0], v0[1]); w.y = cvt_pk_bf16(v0[2], v0[3]); w.z = cvt_pk_bf16(v1[0], v1[1]); w.w = cvt_pk_bf16(v1[2], v1[3]);
                          *(u32x4*)p = w; }
                    }
                }
            }
    }
};

struct MixState { u32x4 g[8]; };
struct EpiMix {
    unsigned char* ws; const float* bm;
    template <class St> DI void operator()(const f32x4 (&acc)[2][2][4][2], const Unit& u, int wr, int wc, int fr, int fq, St& est) const {
        const int j = u.tag >> 1; const unsigned toff = (unsigned)((wr * 4 + wc) * 64 + fq * 16 + fr);
        unsigned char* const gbase = ws + WS_SCRG + (size_t)blockIdx.x * (8 * 512 * 16);
        unsigned char* const abase = ws + WS_MIXACC + (size_t)blockIdx.x * (8 * 512 * 32);
        if ((u.tag & 1) == 0) {
            const float* bp = bm + j * 1024 + u.pn * 256 + wc * 32 + 8 * fq;
            f32x4 b[2][2];
#pragma unroll
            for (int bj = 0; bj < 2; ++bj)
#pragma unroll
                for (int n = 0; n < 2; ++n) b[bj][n] = *(const f32x4*)(bp + bj * 128 + n * 4);
#pragma unroll
            for (int ai = 0; ai < 2; ++ai)
#pragma unroll
                for (int m = 0; m < 4; ++m) {
                    u32x4 w;
#pragma unroll
                    for (int bj = 0; bj < 2; ++bj)
#pragma unroll
                        for (int n = 0; n < 2; ++n) {
                            const f32x4 v = acc[ai][bj][m][n] + b[bj][n];
                            unsigned q = 0u;
                            q = __builtin_amdgcn_cvt_pk_u8_f32(__builtin_rintf(sigmf(v[0]) * 255.f), 0, q); q = __builtin_amdgcn_cvt_pk_u8_f32(__builtin_rintf(sigmf(v[1]) * 255.f), 1, q);
                            q = __builtin_amdgcn_cvt_pk_u8_f32(__builtin_rintf(sigmf(v[2]) * 255.f), 2, q); q = __builtin_amdgcn_cvt_pk_u8_f32(__builtin_rintf(sigmf(v[3]) * 255.f), 3, q);
                            if (bj == 0) { if (n == 0) w.x = q; else w.y = q; } else { if (n == 0) w.z = q; else w.w = q; }
                        }
                    est.g[ai * 4 + m] = w;
                }
        } else {
            const int row0 = u.pm * 256 + wr * 64 + fr;
            bf16_t* const MIXED = (bf16_t*)(ws + WS_MIXED);
#pragma unroll
            for (int ai = 0; ai < 2; ++ai)
#pragma unroll
                for (int m = 0; m < 4; ++m) {
                    asm volatile("" ::: "memory");
                    const u32x4 gq = est.g[ai * 4 + m];
                    u32x4* ap = (u32x4*)(abase + (ai * 4 + m) * (512 * 32) + toff * 32u);
                    u32x4 m0 = (u32x4){0u, 0u, 0u, 0u}, m1 = m0;
                    if (j > 0) { m0 = ap[0]; m1 = ap[1]; }
                    u32x4 r0, r1;
#pragma unroll
                    for (int bj = 0; bj < 2; ++bj) {
                        const u32x4 mm = bj ? m1 : m0;
#pragma unroll
                        for (int n = 0; n < 2; ++n) {
                            const unsigned gw_ = (bj == 0) ? (n ? gq.y : gq.x) : (n ? gq.w : gq.z), ax = n ? mm.z : mm.x, ay = n ? mm.w : mm.y; const f32x4 a = acc[ai][bj][m][n] * (1.f / 255.f);
                            f32x4 v; v[0] = (float)(gw_ & 0xffu) * a[0] + bflo(ax); v[1] = (float)((gw_ >> 8) & 0xffu) * a[1] + bfhi(ax); v[2] = (float)((gw_ >> 16) & 0xffu) * a[2] + bflo(ay); v[3] = (float)(gw_ >> 24) * a[3] + bfhi(ay);
                            const unsigned wx = cvt_pk_bf16(v[0], v[1]), wy = cvt_pk_bf16(v[2], v[3]);
                            if (j < 3) { if (bj == 0) { if (n == 0) { r0.x = wx; r0.y = wy; } else { r0.z = wx; r0.w = wy; } } else { if (n == 0) { r1.x = wx; r1.y = wy; } else { r1.z = wx; r1.w = wy; } } }
                            else { u32x2 w; w.x = wx; w.y = wy;
                                *(u32x2*)(MIXED + (size_t)(row0 + ai * 128 + m * 16) * 1024 + u.pn * 256 + bj * 128 + wc * 32 + 8 * fq + n * 4) = w; }
                        }
                    }
                    if (j < 3) { ap[0] = r0; ap[1] = r1; }
                }
        }
    }
};

struct EpiOut {
    const float* base; float* out;
    template <class St> DI void operator()(const f32x4 (&acc)[2][2][4][2], const Unit& u, int wr, int wc, int fr, int fq, St& est) const {
        const int row0 = u.pm * 256 + wr * 64 + fr; const float sc = u.tag ? 0.f : 1.f;
        const size_t col0 = (size_t)u.pn * 256 + wc * 32 + 8 * fq;
        f32x4 nb[4];
#pragma unroll
        for (int q = 0; q < 4; ++q) nb[q] = *(const f32x4*)(base + (size_t)row0 * 1024 + col0 + (q >> 1) * 128 + (q & 1) * 4);
#pragma unroll
        for (int g8 = 0; g8 < 8; ++g8) {
            const int ai = g8 >> 2, m = g8 & 3;
            f32x4 cb[4];
#pragma unroll
            for (int q = 0; q < 4; ++q) cb[q] = nb[q];
            asm volatile("" ::: "memory");
            if (g8 + 1 < 8) { const int ai1 = (g8 + 1) >> 2, m1 = (g8 + 1) & 3; const size_t off1 = (size_t)(row0 + ai1 * 128 + m1 * 16) * 1024 + col0;
#pragma unroll
                for (int q = 0; q < 4; ++q) nb[q] = *(const f32x4*)(base + off1 + (q >> 1) * 128 + (q & 1) * 4); }
            const size_t off = (size_t)(row0 + ai * 128 + m * 16) * 1024 + col0;
#pragma unroll
            for (int q = 0; q < 4; ++q) *(f32x4*)(out + off + (q >> 1) * 128 + (q & 1) * 4) = cb[q] + acc[ai][q >> 1][m][q & 1] * sc;
        }
    }
};

template <class F>
DI void prep_mat(F f, bf16_t* dst, int N, int K, LAS float* scr, int gw, int NGW, int lane) {
    const int nblk = N / 32, items = (K / 64) * nblk;
    #pragma clang loop vectorize(disable) interleave(disable) unroll(disable)
    for (int it = gw; it < items; it += NGW) {
        const int kb = it / nblk, nb = it % nblk, k0 = kb * 64, n0 = nb * 32;
#pragma unroll
        for (int i = 0; i < 8; ++i) { const int kk = 8 * i + (lane >> 3), n4 = (lane & 7) * 4; const f32x4 v = f(k0 + kk, n0 + n4);
            LAS float* d = scr + kk * 33 + n4; d[0] = v[0]; d[1] = v[1]; d[2] = v[2]; d[3] = v[3]; }
        asm volatile("s_waitcnt lgkmcnt(0)" ::: "memory");
        const int c = lane & 7;
#pragma unroll
        for (int j = 0; j < 4; ++j) {
            const int n = (lane >> 3) + 8 * j; const LAS float* s = scr + (8 * c) * 33 + n;
            u32x4 o; o.x = cvt_pk_bf16(s[0], s[33]); o.y = cvt_pk_bf16(s[2 * 33], s[3 * 33]); o.z = cvt_pk_bf16(s[4 * 33], s[5 * 33]); o.w = cvt_pk_bf16(s[6 * 33], s[7 * 33]);
            *(u32x4*)(dst + (size_t)(n0 + n) * K + k0 + 8 * c) = o;
        }
        asm volatile("s_waitcnt lgkmcnt(0)" ::: "memory");
    }
}
DI int map_in(int n) {
    const int t = n >> 8, c = n & 255;
    if (t == 0) return pcol(c);
    if (t == 1) { if (c < 128) return 256 + pcol(c); if (c < 192) return 384 + rope_perm(c - 128); if (c < 208) return 5312 + (c - 192); if (c < 224) return 5328 + (c - 208); return -1; }
    if (t <= 10) { const int s = t - 2, which = s % 3; const int cc = (which == 2) ? pcol(c) : ((c & ~63) | rope_perm(c & 63)); return 448 + s * 256 + cc; }
    if (t <= 16) return 2752 + (t - 11) * 256 + pcol(c);
    if (t <= 20) return 4288 + (t - 17) * 256 + pcol(c);
    return 5344 + (t - 21) * 256 + pcol(c);
}

struct Params { const float* in[21]; float* out; unsigned char* ws; int ph_lo, ph_hi; };
typedef const __attribute__((address_space(4))) Params* KP;

DI void phase_prep(KP p, LAS unsigned char* lds, int tid, int wave, int lane, int G) {
    LAS float* scr = (LAS float*)(lds + wave * 16384);
    const int gw = blockIdx.x * 8 + wave, NGW = G * 8;
    for (int l = 0; l < 2; ++l) {
        unsigned char* wb = p->ws + WS_W + l * W_LSTRIDE;
        { const float* w = p->in[2] + (size_t)l * DM * DIN;
          prep_mat([=](int k, int n) -> f32x4 { const int c = map_in(n); return c < 0 ? (f32x4){0.f, 0.f, 0.f, 0.f} : *(const f32x4*)(w + (size_t)k * DIN + c); }, (bf16_t*)(wb + W_1T), 7168, 1024, scr, gw, NGW, lane); }
        { const float* w = p->in[17] + (size_t)l * DM * 4096;
          prep_mat([=](int k, int n) -> f32x4 { return *(const f32x4*)(w + (size_t)k * 4096 + pcol(n)); }, (bf16_t*)(wb + W_GT), 4096, 1024, scr, gw, NGW, lane); }
        { const float* wq = p->in[4] + (size_t)l * 256 * 768; const float* gq = p->in[3] + l * 256;
          prep_mat([=](int k, int n) -> f32x4 { const int t = n >> 8, c = n & 255;
              const int nl = pcol(n); const int col = (t < 2) ? ((nl >> 7) * 192 + (nl & 127)) : ((c >> 6) * 192 + 128 + rope_perm(c & 63)); return *(const f32x4*)(wq + (size_t)k * 768 + col) * gq[k]; }, (bf16_t*)(wb + W_UP), 768, 256, scr, gw, NGW, lane); }
        { const float* wkv = p->in[6] + (size_t)l * 128 * 1024; const float* gkv = p->in[5] + l * 128;
          prep_mat([=](int k, int n) -> f32x4 { const int nn = pcol(n) & 511; const int col = (nn >> 7) * 256 + (n >= 512 ? 128 : 0) + (nn & 127); return *(const f32x4*)(wkv + (size_t)k * 1024 + col) * gkv[k]; },
                   (bf16_t*)(wb + W_UP + 768 * 256 * 2), 1024, 128, scr, gw, NGW, lane); }
        { const float* w = p->in[13] + (size_t)l * 512 * 1024; prep_mat([=](int k, int n) -> f32x4 { return *(const f32x4*)(w + (size_t)k * 1024 + pcol(n)); }, (bf16_t*)(wb + W_PA), 1024, 512, scr, gw, NGW, lane); }
        { const float* w = p->in[14] + (size_t)l * 256 * 1024; prep_mat([=](int k, int n) -> f32x4 { return *(const f32x4*)(w + (size_t)k * 1024 + pcol(n)); }, (bf16_t*)(wb + W_PB), 1024, 256, scr, gw, NGW, lane); }
        { const float* w = p->in[15] + (size_t)l * 512 * 1024; prep_mat([=](int k, int n) -> f32x4 { return *(const f32x4*)(w + (size_t)k * 1024 + pcol(n)); }, (bf16_t*)(wb + W_PC), 1024, 512, scr, gw, NGW, lane); }
        { const float* w = p->in[16] + (size_t)l * 512 * 1024; prep_mat([=](int k, int n) -> f32x4 { return *(const f32x4*)(w + (size_t)k * 1024 + pcol(n)); }, (bf16_t*)(wb + W_PD), 1024, 512, scr, gw, NGW, lane); }
        { const float* w = p->in[19] + (size_t)l * 1024 * 1024; prep_mat([=](int k, int n) -> f32x4 { return *(const f32x4*)(w + (size_t)k * 1024 + pcol(n)); }, (bf16_t*)(wb + W_OUT), 1024, 1024, scr, gw, NGW, lane); }
    }
    float* rc = (float*)(p->ws + WS_ROPEC); float* rs = (float*)(p->ws + WS_ROPES);
    #pragma clang loop vectorize(disable) interleave(disable) unroll(disable)
    for (int e = blockIdx.x * 512 + tid; e < SEQ * 32; e += G * 512) {
        const int pos = e >> 5, i = e & 31;
        const float inv = exp2f(-(float)i * (13.287712379549449f / 32.f));
        const float ang = (float)pos * inv;
        const float nrev = rintf(ang * 0.15915494309189535f);
        float r = fmaf(-nrev, 6.28125f, ang); r = fmaf(-nrev, 1.9353071795864769e-3f, r);
        rc[e] = __cosf(r); rs[e] = __sinf(r);
    }
}

DI void phase_rms(const float* xsrc, const float* gain, bf16_t* H, float* SSQ, int tid, int wave, int lane, int G) {
    const int gw = blockIdx.x * 8 + wave, NGW = G * 8;
    #pragma clang loop vectorize(disable) interleave(disable) unroll(disable)
    for (int m = gw; m < TG; m += NGW) {
        const f32x4* xr = (const f32x4*)(xsrc + (size_t)m * DM) + lane;
        f32x4 v[4]; float s = 0.f;
#pragma unroll
        for (int j = 0; j < 4; ++j) { v[j] = xr[64 * j]; s += v[j][0] * v[j][0] + v[j][1] * v[j][1] + v[j][2] * v[j][2] + v[j][3] * v[j][3]; }
        const float r = rsqrtf(wave_sum(s, lane) * (1.f / DM) + EPS);
        u32x2* o = (u32x2*)(H + (size_t)m * DM) + lane;
#pragma unroll
        for (int j = 0; j < 4; ++j) { const f32x4 g = ((const f32x4*)gain)[lane + 64 * j]; u32x2 w; w.x = cvt_pk_bf16(v[j][0] * r * g[0], v[j][1] * r * g[1]); w.y = cvt_pk_bf16(v[j][2] * r * g[2], v[j][3] * r * g[3]); o[64 * j] = w; }
    }
    #pragma clang loop vectorize(disable) interleave(disable) unroll(disable)
    for (int e = blockIdx.x * 512 + tid; e < TG * 2; e += G * 512) SSQ[e] = 0.f;
}
DI void phase_final(float* x, const float* gain, int wave, int lane, int G) {
    const int gw = blockIdx.x * 8 + wave, NGW = G * 8;
    #pragma clang loop vectorize(disable) interleave(disable) unroll(disable)
    for (int m = gw; m < TG * NGRP; m += NGW) {
        f32x4* xr = (f32x4*)(x + (size_t)m * DM) + lane;
        f32x4 v[4]; float s = 0.f;
#pragma unroll
        for (int j = 0; j < 4; ++j) { v[j] = xr[64 * j]; s += v[j][0] * v[j][0] + v[j][1] * v[j][1] + v[j][2] * v[j][2] + v[j][3] * v[j][3]; }
        const float r = rsqrtf(wave_sum(s, lane) * (1.f / DM) + EPS);
#pragma unroll
        for (int j = 0; j < 4; ++j) { const f32x4 g = ((const f32x4*)gain)[lane + 64 * j]; xr[64 * j] = v[j] * r * g; }
    }
}

constexpr int GL_LAF = 0, GL_LAB = 16384, GL_KTF = 32768, GL_KTB = 32768 + 9216, GL_V1 = 32768 + 18432;
constexpr int G3_V = 32768, G3_SF = 32768 + 17408, G3_SB = 32768 + 2 * 17408;
constexpr int GLW_G = 104448, GLW_W = 104448 + 8192;
DI void gla_la_store(LAS unsigned char* lds, const float* GFB, const float* wgf, const float* bgf, const float* wgb, const float* bgb, int tok0, int h, int tid) {
    {
        const int row = tid >> 3, c4 = (tid & 7) * 4;
        const f32x4 gv_ = *(const f32x4*)(GFB + (size_t)(tok0 + row) * 32 + c4);
        const int idx = tid * 4, dir_ = idx >> 10, r_ = (idx >> 6) & 15, dk_ = idx & 63;
        const f32x4 wv_ = *(const f32x4*)((dir_ ? wgb : wgf) + r_ * 256 + h * 64 + dk_);
        *(LAS f32x4*)(lds + GLW_G + (row * 32 + c4) * 4) = gv_;
        *(LAS f32x4*)(lds + GLW_W + idx * 4) = wv_;
    }
    __syncthreads();
    {
        const int tok = tid >> 3, dk0 = (tid & 7) * 8;
        const LAS float* gp = (const LAS float*)(lds + GLW_G) + tok * 32;
#pragma unroll
        for (int dir = 0; dir < 2; ++dir) {
            const LAS float* w = (const LAS float*)(lds + GLW_W) + dir * 1024 + dk0; const float* b = (dir ? bgb : bgf) + h * 64 + dk0;
            f32x4 a0 = *(const f32x4*)b, a1 = *(const f32x4*)(b + 4);
#pragma unroll
            for (int r4 = 0; r4 < 4; ++r4) { const f32x4 gv = *(const LAS f32x4*)(gp + dir * 16 + r4 * 4);
#pragma unroll
                for (int e = 0; e < 4; ++e) { const int r = r4 * 4 + e; a0 += gv[e] * *(const LAS f32x4*)(w + r * 64); a1 += gv[e] * *(const LAS f32x4*)(w + r * 64 + 4); } }
            LAS float* o = (LAS float*)(lds + (dir ? GL_LAB : GL_LAF)) + tok * 64 + dk0;
            f32x4 r0, r1;
#pragma unroll
            for (int e = 0; e < 4; ++e) { const float x0 = a0[e], x1 = a1[e];
                r0[e] = (fminf(x0, 0.f) - __logf(1.0f + __expf(-fabsf(x0)))) * (1.f / 16.f); r1[e] = (fminf(x1, 0.f) - __logf(1.0f + __expf(-fabsf(x1)))) * (1.f / 16.f); }
            *(LAS f32x4*)o = r0; *(LAS f32x4*)(o + 4) = r1;
        }
    }
}
DI void gla_cumsum(LAS unsigned char* lds, int tid) {
    __syncthreads();
    const int col = tid & 127, seg = tid >> 7, dir = col >> 6, dk = col & 63;
    LAS float* a = (LAS float*)(lds + (dir ? GL_LAB : GL_LAF)) + dk + seg * 16 * 64;
    LAS float* tot = (LAS float*)(lds + GLW_G);
    float v[16];
#pragma unroll
    for (int t = 0; t < 16; ++t) v[t] = a[t * 64];
    if (dir == 0) {
#pragma unroll
        for (int t = 1; t < 16; ++t) v[t] += v[t - 1];
        tot[seg * 128 + col] = v[15];
    } else {
#pragma unroll
        for (int t = 14; t >= 0; --t) v[t] += v[t + 1];
        tot[seg * 128 + col] = v[0];
    }
    __syncthreads();
    float off = 0.f;
#pragma unroll
    for (int s2 = 0; s2 < 4; ++s2) { const float tt = tot[s2 * 128 + col]; off += ((dir == 0) ? (s2 < seg) : (s2 > seg)) ? tt : 0.f; }
#pragma unroll
    for (int t = 0; t < 16; ++t) a[t * 64] = v[t] + off;
    __syncthreads();
}

DI void gla_g1_item(LAS unsigned char* lds, KP p, int l, int item, int tid, int wave, int lane) {
    const int n = item & 63, h = (item >> 6) & 3, bl = item >> 8, tok0 = bl * SEQ + n * 64;
    const float* GFB = (const float*)(p->ws + WS_GFB);
    const bf16_t* DK = (const bf16_t*)(p->ws + WS_DK); const bf16_t* DV = (const bf16_t*)(p->ws + WS_DV);
    {
        const int tok = tid >> 3, dk0 = (tid & 7) * 8;
        const u32x4 kr = *(const u32x4*)(DK + (size_t)(tok0 + tok) * 256 + h * 64 + dk0);
        u32x4 vst[2];
#pragma unroll
        for (int i = 0; i < 2; ++i) { const int c = tid + 512 * i, row = c >> 4, ch = c & 15; vst[i] = *(const u32x4*)(DV + (size_t)(tok0 + row) * 512 + h * 128 + ch * 8); }
        gla_la_store(lds, GFB, p->in[8] + l * 4096, p->in[9] + l * 256, p->in[10] + l * 4096, p->in[11] + l * 256, tok0, h, tid);
#pragma unroll
        for (int i = 0; i < 2; ++i) { const int c = tid + 512 * i, row = c >> 4, ch = c & 15; *(LAS u32x4*)(lds + GL_V1 + row * 272 + ch * 16) = vst[i]; }
        gla_cumsum(lds, tid);
        const LAS float* lf = (const LAS float*)(lds + GL_LAF); const LAS float* lb = (const LAS float*)(lds + GL_LAB);
        float kf[8], kb[8];
        const f32x4 fl0 = *(const LAS f32x4*)(lf + 63 * 64 + dk0), fl1 = *(const LAS f32x4*)(lf + 63 * 64 + dk0 + 4), ft0 = *(const LAS f32x4*)(lf + tok * 64 + dk0), ft1 = *(const LAS f32x4*)(lf + tok * 64 + dk0 + 4);
        const f32x4 bl0 = *(const LAS f32x4*)(lb + dk0), bl1 = *(const LAS f32x4*)(lb + dk0 + 4), bt0 = *(const LAS f32x4*)(lb + tok * 64 + dk0), bt1 = *(const LAS f32x4*)(lb + tok * 64 + dk0 + 4);
        { unsigned char* lac = p->ws + WS_LAC + (size_t)item * 16384 + (size_t)(tok * 64 + dk0) * 2;
          const f32x8 vf = {ft0[0], ft0[1], ft0[2], ft0[3], ft1[0], ft1[1], ft1[2], ft1[3]}, vb = {bt0[0], bt0[1], bt0[2], bt0[3], bt1[0], bt1[1], bt1[2], bt1[3]};
          *(h16x8*)lac = __builtin_convertvector(vf, h16x8); *(h16x8*)(lac + 8192) = __builtin_convertvector(vb, h16x8); }
#pragma unroll
        for (int e = 0; e < 8; ++e) { const unsigned w = (e < 2) ? kr.x : (e < 4) ? kr.y : (e < 6) ? kr.z : kr.w; const float kv = (e & 1) ? bfhi(w) : bflo(w);
            const float fl = (e < 4) ? fl0[e & 3] : fl1[e & 3], ft = (e < 4) ? ft0[e & 3] : ft1[e & 3], bl_ = (e < 4) ? bl0[e & 3] : bl1[e & 3], bt = (e < 4) ? bt0[e & 3] : bt1[e & 3];
            kf[e] = kv * __expf(fl - ft); kb[e] = kv * __expf(bl_ - bt); }
        u32x4 o; o.x = cvt_pk_bf16(kf[0], kf[1]); o.y = cvt_pk_bf16(kf[2], kf[3]); o.z = cvt_pk_bf16(kf[4], kf[5]); o.w = cvt_pk_bf16(kf[6], kf[7]);
        *(LAS u32x4*)(lds + GL_KTF + tok * 144 + dk0 * 2) = o;
        o.x = cvt_pk_bf16(kb[0], kb[1]); o.y = cvt_pk_bf16(kb[2], kb[3]); o.z = cvt_pk_bf16(kb[4], kb[5]); o.w = cvt_pk_bf16(kb[6], kb[7]);
        *(LAS u32x4*)(lds + GL_KTB + tok * 144 + dk0 * 2) = o;
        if (tid < 128) { const int dir = tid >> 6, dk = tid & 63; float* DEC = (float*)(p->ws + WS_DEC);
            DEC[(size_t)(((dir * 16 + bl * 4 + h) * 64) + n) * 64 + dk] = __expf(dir ? lb[dk] : lf[63 * 64 + dk]); }
    }
    __syncthreads();
    {
        const int dir = wave >> 2, mt = wave & 3, i16 = lane & 15, g4 = lane >> 4, qq = i16 >> 2, pp = i16 & 3;
        LAS unsigned char* kt = lds + (dir ? GL_KTB : GL_KTF);
        bf16x8 af[2];
#pragma unroll
        for (int ks = 0; ks < 2; ++ks) { const int r0 = ks * 32 + 8 * g4 + qq;
            af[ks] = cat8(trread(kt + r0 * 144 + (mt * 16 + 4 * pp) * 2), trread(kt + (r0 + 4) * 144 + (mt * 16 + 4 * pp) * 2)); }
        bf16_t* KV = (bf16_t*)(p->ws + WS_KV) + (size_t)(((dir * 16 + bl * 4 + h) * 64) + n) * 8192;
#pragma unroll
        for (int nt = 0; nt < 8; ++nt) {
            f32x4 c = {0.f, 0.f, 0.f, 0.f};
#pragma unroll
            for (int ks = 0; ks < 2; ++ks) { const int r0 = ks * 32 + 8 * g4 + qq;
                const bf16x8 bfr = cat8(trread(lds + GL_V1 + r0 * 272 + (nt * 16 + 4 * pp) * 2), trread(lds + GL_V1 + (r0 + 4) * 272 + (nt * 16 + 4 * pp) * 2));
                c = mfma16(af[ks], bfr, c); }
#pragma unroll
            for (int r = 0; r < 4; ++r) KV[(size_t)(mt * 16 + 4 * g4 + r) * 128 + nt * 16 + i16] = (bf16_t)(cvt_pk_bf16(c[r], 0.f) & 0xffffu);
        }
    }
    __syncthreads();
}

DI void gla_scan(KP p, int G, int tid) {
    unsigned* KV = (unsigned*)(p->ws + WS_KV); const float* DEC = (const float*)(p->ws + WS_DEC);
    #pragma clang loop vectorize(disable) interleave(disable) unroll(disable)
    for (int e = blockIdx.x * 512 + tid; e < 2 * 16 * 4096; e += G * 512) {
        const int dir = e >> 16, blh = (e >> 12) & 15, pidx = e & 4095, dk = pidx >> 6;
        unsigned* kv = KV + (size_t)((dir * 16 + blh) * 64) * 4096 + pidx; const float* dc = DEC + (size_t)((dir * 16 + blh) * 64) * 64 + dk;
        float s0 = 0.f, s1 = 0.f;
        for (int b = 0; b < 4; ++b) {
            unsigned w[16]; float d[16];
#pragma unroll
            for (int i = 0; i < 16; ++i) { const int st = b * 16 + i, n = dir ? 63 - st : st; w[i] = kv[(size_t)n * 4096]; d[i] = dc[n * 64]; }
#pragma unroll
            for (int i = 0; i < 16; ++i) { const int st = b * 16 + i, n = dir ? 63 - st : st; kv[(size_t)n * 4096] = cvt_pk_bf16(s0, s1); s0 = d[i] * s0 + bflo(w[i]); s1 = d[i] * s1 + bfhi(w[i]); }
        }
    }
}

DI void gla_g3_item(LAS unsigned char* lds, KP p, int l, int item, int tid, int wave, int lane) {
    const int n = item & 63, h = (item >> 6) & 3, bl = item >> 8, tok0 = bl * SEQ + n * 64;
    const float* GFB = (const float*)(p->ws + WS_GFB);
    const bf16_t* DQ = (const bf16_t*)(p->ws + WS_DQ); const bf16_t* DK = (const bf16_t*)(p->ws + WS_DK); const bf16_t* DV = (const bf16_t*)(p->ws + WS_DV);
    const int dir = wave >> 2, it = wave & 3, i16 = lane & 15, g4 = lane >> 4, qq = i16 >> 2, pp = i16 & 3;
    u32x4 qraw[2], kraw[4][2];
#pragma unroll
    for (int ks = 0; ks < 2; ++ks) qraw[ks] = *(const u32x4*)(DQ + (size_t)(tok0 + it * 16 + i16) * 256 + h * 64 + ks * 32 + 8 * g4);
#pragma unroll
    for (int jt = 0; jt < 4; ++jt)
#pragma unroll
        for (int ks = 0; ks < 2; ++ks) kraw[jt][ks] = *(const u32x4*)(DK + (size_t)(tok0 + jt * 16 + i16) * 256 + h * 64 + ks * 32 + 8 * g4);
    {
        u32x4 stg[6];
#pragma unroll
        for (int i = 0; i < 2; ++i) { const int c = tid + 512 * i, row = c >> 4, ch = c & 15; stg[i] = *(const u32x4*)(DV + (size_t)(tok0 + row) * 512 + h * 128 + ch * 8); }
#pragma unroll
        for (int d2 = 0; d2 < 2; ++d2) {
            const bf16_t* KV = (const bf16_t*)(p->ws + WS_KV) + (size_t)(((d2 * 16 + bl * 4 + h) * 64) + n) * 8192;
#pragma unroll
            for (int i = 0; i < 2; ++i) { const int c = tid + 512 * i, row = c >> 4, ch = c & 15; stg[2 + d2 * 2 + i] = *(const u32x4*)(KV + (size_t)row * 128 + ch * 8); }
        }
        { const int tok_ = tid >> 3, dk0_ = (tid & 7) * 8;
          const unsigned char* lac = p->ws + WS_LAC + (size_t)item * 16384 + (size_t)(tok_ * 64 + dk0_) * 2;
          const f32x8 vf = __builtin_convertvector(*(const h16x8*)lac, f32x8), vb = __builtin_convertvector(*(const h16x8*)(lac + 8192), f32x8);
          LAS float* of = (LAS float*)(lds + GL_LAF) + tok_ * 64 + dk0_; LAS float* ob = (LAS float*)(lds + GL_LAB) + tok_ * 64 + dk0_;
          *(LAS f32x4*)of = (f32x4){vf[0], vf[1], vf[2], vf[3]}; *(LAS f32x4*)(of + 4) = (f32x4){vf[4], vf[5], vf[6], vf[7]};
          *(LAS f32x4*)ob = (f32x4){vb[0], vb[1], vb[2], vb[3]}; *(LAS f32x4*)(ob + 4) = (f32x4){vb[4], vb[5], vb[6], vb[7]}; }
#pragma unroll
        for (int i = 0; i < 2; ++i) { const int c = tid + 512 * i, row = c >> 4, ch = c & 15;
            *(LAS u32x4*)(lds + G3_V + row * 272 + ch * 16) = stg[i]; *(LAS u32x4*)(lds + G3_SF + row * 272 + ch * 16) = stg[2 + i]; *(LAS u32x4*)(lds + G3_SB + row * 272 + ch * 16) = stg[4 + i]; }
    }
    __syncthreads();
    f32x4 o[8];
    {
        const LAS float* la = (const LAS float*)(lds + (dir ? GL_LAB : GL_LAF));
        const int midrow = dir ? 32 : 31, qi = it * 16 + i16;
        bf16x8 qt[2], qh[2]; f32x4 lmid[2][2];
#pragma unroll
        for (int ks = 0; ks < 2; ++ks) {
            const int d0 = ks * 32 + 8 * g4;
            const u32x4 qr = qraw[ks];
            float a[8], b[8];
            const f32x4 bq0 = *(const LAS f32x4*)(la + qi * 64 + d0), bq1 = *(const LAS f32x4*)(la + qi * 64 + d0 + 4);
            const f32x4 bm0 = *(const LAS f32x4*)(la + midrow * 64 + d0), bm1 = *(const LAS f32x4*)(la + midrow * 64 + d0 + 4);
            lmid[ks][0] = bm0; lmid[ks][1] = bm1;
#pragma unroll
            for (int e = 0; e < 8; ++e) { const unsigned w = (e < 2) ? qr.x : (e < 4) ? qr.y : (e < 6) ? qr.z : qr.w; const float qv = (e & 1) ? bfhi(w) : bflo(w);
                const float bi = (e < 4) ? bq0[e & 3] : bq1[e & 3], bm = (e < 4) ? bm0[e & 3] : bm1[e & 3]; a[e] = qv * __expf(bi - bm); b[e] = qv * __expf(bi); }
            qt[ks] = pack8((f32x4){a[0], a[1], a[2], a[3]}, (f32x4){a[4], a[5], a[6], a[7]});
            qh[ks] = pack8((f32x4){b[0], b[1], b[2], b[3]}, (f32x4){b[4], b[5], b[6], b[7]});
        }
        f32x4 att[4];
#pragma unroll
        for (int jt = 0; jt < 4; ++jt) {
            att[jt] = (f32x4){0.f, 0.f, 0.f, 0.f};
            const int kj = jt * 16 + i16;
#pragma unroll
            for (int ks = 0; ks < 2; ++ks) {
                const int d0 = ks * 32 + 8 * g4;
                const u32x4 kr = kraw[jt][ks];
                float a[8];
                const f32x4 bk0 = *(const LAS f32x4*)(la + kj * 64 + d0), bk1 = *(const LAS f32x4*)(la + kj * 64 + d0 + 4);
#pragma unroll
                for (int e = 0; e < 8; ++e) { const unsigned w = (e < 2) ? kr.x : (e < 4) ? kr.y : (e < 6) ? kr.z : kr.w; const float kv = (e & 1) ? bfhi(w) : bflo(w);
                    const float bk = (e < 4) ? bk0[e & 3] : bk1[e & 3], bm = (e < 4) ? lmid[ks][0][e & 3] : lmid[ks][1][e & 3]; a[e] = kv * __expf(bm - bk); }
                att[jt] = mfma16(pack8((f32x4){a[0], a[1], a[2], a[3]}, (f32x4){a[4], a[5], a[6], a[7]}), qt[ks], att[jt]);
            }
#pragma unroll
            for (int r = 0; r < 4; ++r) { const int j = jt * 16 + 4 * g4 + r; const bool keep = dir ? (j >= qi) : (j <= qi); att[jt][r] = keep ? att[jt][r] : 0.f; }
        }
        bf16x8 pf[2]; pf[0] = pack8(att[0], att[1]); pf[1] = pack8(att[2], att[3]);
        LAS unsigned char* sb = lds + (dir ? G3_SB : G3_SF);
#pragma unroll
        for (int dt = 0; dt < 8; ++dt) {
            f32x4 c = {0.f, 0.f, 0.f, 0.f};
            const int cb = (dt * 16 + 4 * pp) * 2;
#pragma unroll
            for (int s2 = 0; s2 < 2; ++s2) {
                const int ra = (2 * s2) * 16 + 4 * g4 + qq;
                c = mfma16(cat8(trread(lds + G3_V + ra * 272 + cb), trread(lds + G3_V + (ra + 16) * 272 + cb)), pf[s2], c);
            }
#pragma unroll
            for (int ks = 0; ks < 2; ++ks) {
                const int r0 = ks * 32 + 8 * g4 + qq;
                c = mfma16(cat8(trread(sb + r0 * 272 + cb), trread(sb + (r0 + 4) * 272 + cb)), qh[ks], c);
            }
            o[dt] = c;
        }
    }
    __syncthreads();
    LAS float* xo = (LAS float*)lds;
    if (dir == 1) {
#pragma unroll
        for (int dt = 0; dt < 8; ++dt)
#pragma unroll
            for (int r = 0; r < 4; ++r) xo[(it * 128 + dt * 16 + 4 * g4 + r) * 16 + i16] = o[dt][r];
    }
    __syncthreads();
    if (dir == 0) {
        float ss = 0.f;
#pragma unroll
        for (int dt = 0; dt < 8; ++dt)
#pragma unroll
            for (int r = 0; r < 4; ++r) { o[dt][r] += xo[(it * 128 + dt * 16 + 4 * g4 + r) * 16 + i16]; ss += o[dt][r] * o[dt][r]; }
        ss += shx(ss, 16, lane); ss += shx(ss, 32, lane);
        const float rn = rsqrtf(ss * (1.f / 128.f) + EPS);
        const int tok = tok0 + it * 16 + i16;
        const float* gn = p->in[12] + l * 512 + h * 128;
        const bf16_t* Z = (const bf16_t*)(p->ws + WS_Z) + (size_t)tok * 1792 + 1280 + h * 128;
        bf16_t* OD = (bf16_t*)(p->ws + WS_OD) + (size_t)tok * 512 + h * 128;
#pragma unroll
        for (int dt = 0; dt < 8; ++dt) {
            const int d = dt * 16 + 4 * g4;
            const f32x4 g = *(const f32x4*)(gn + d); const u32x2 z = *(const u32x2*)(Z + d);
            u32x2 w; w.x = cvt_pk_bf16(o[dt][0] * rn * g[0] * bflo(z.x), o[dt][1] * rn * g[1] * bfhi(z.x)); w.y = cvt_pk_bf16(o[dt][2] * rn * g[2] * bflo(z.y), o[dt][3] * rn * g[3] * bfhi(z.y));
            *(u32x2*)(OD + d) = w;
        }
    }
    __syncthreads();
}

constexpr int DL_K = 0, DL_V = 49152;
DI void dil_load(KP p, int item, int tid, u32x4 (&kr)[6], u32x4 (&vr)[6]) {
    const int hp = item & 1, sb = ((item >> 1) & 3) * 16 + ((item >> 3) & 15), bg_ = item >> 7, g = bg_ % 3, bl = bg_ / 3;
    const int lg = 2 * g, r = 1 << lg, L = SEQ >> lg, bpr = 64 >> lg, mres = sb / bpr, nb = sb % bpr;
    const bf16_t* Kb = (const bf16_t*)(p->ws + WS_BQKV) + (size_t)(g * 3 + 1) * TG * 256;
    const bf16_t* Vb = (const bf16_t*)(p->ws + WS_BQKV) + (size_t)(g * 3 + 2) * TG * 256;
#pragma unroll
    for (int i = 0; i < 6; ++i) {
        const int c = tid + 512 * i, kl = c >> 4, part = c & 15, ik = nb * 64 - 64 + kl;
        const bool ok = (ik >= 0) && (ik < L);
        const size_t tok = (size_t)bl * SEQ + (size_t)(ok ? ik : 0) * r + mres;
        u32x4 kv = *(const u32x4*)(Kb + tok * 256 + hp * 128 + part * 8), vv = *(const u32x4*)(Vb + tok * 256 + hp * 128 + part * 8);
        if (!ok) { kv = (u32x4){0u, 0u, 0u, 0u}; vv = kv; }
        kr[i] = kv; vr[i] = vv;
    }
}
DI void dil_store(LAS unsigned char* lds, int tid, const u32x4 (&kr)[6], const u32x4 (&vr)[6]) {
#pragma unroll
    for (int i = 0; i < 6; ++i) {
        const int c = tid + 512 * i, kl = c >> 4, part = c & 15, hh = part >> 3, piece = part & 7;
        const int off = (hh * 192 + kl) * 128 + ((piece ^ (kl & 7)) * 16);
        *(LAS u32x4*)(lds + DL_K + off) = kr[i]; *(LAS u32x4*)(lds + DL_V + off) = vr[i];
    }
}
DI void dil_compute(LAS unsigned char* lds, KP p, int item, int tid, int wave, int lane) {
    const int hp = item & 1, sb = ((item >> 1) & 3) * 16 + ((item >> 3) & 15), bg_ = item >> 7, g = bg_ % 3, bl = bg_ / 3;
    const int lg = 2 * g, r = 1 << lg, L = SEQ >> lg, bpr = 64 >> lg, mres = sb / bpr, nb = sb % bpr;
    const bf16_t* Qb = (const bf16_t*)(p->ws + WS_BQKV) + (size_t)(g * 3 + 0) * TG * 256;
    {
        const int hh = wave >> 2, qt = wave & 3, i16 = lane & 15, g4 = lane >> 4, qq = i16 >> 2, pp = i16 & 3;
        const int head = hp * 2 + hh, qi = qt * 16 + i16, iq = nb * 64 + qi;
        const size_t tokq = (size_t)bl * SEQ + (size_t)iq * r + mres;
        const bf16x8 qf0 = *(const bf16x8*)(Qb + tokq * 256 + head * 64 + 8 * g4), qf1 = *(const bf16x8*)(Qb + tokq * 256 + head * 64 + 32 + 8 * g4);
        f32x4 st[9];
        float mx = -1e30f;
#pragma unroll
        for (int t = 0; t < 9; ++t) {
            const int row = (qt + t) * 16 + i16;
            const LAS unsigned char* kp = lds + DL_K + (hh * 192 + row) * 128;
            f32x4 c = {0.f, 0.f, 0.f, 0.f};
            c = mfma16(*(const LAS bf16x8*)(kp + ((g4 ^ (row & 7)) * 16)), qf0, c);
            c = mfma16(*(const LAS bf16x8*)(kp + (((4 + g4) ^ (row & 7)) * 16)), qf1, c);
#pragma unroll
            for (int rr = 0; rr < 4; ++rr) {
                const int kl = (qt + t) * 16 + 4 * g4 + rr, ql = 64 + qi, ik = nb * 64 - 64 + kl, dlt = kl - ql;
                const bool ok = (dlt <= 64) && (dlt >= -64) && (ik >= 0) && (ik < L);
                c[rr] = ok ? c[rr] * LOG2E : -1e30f; mx = fmaxf(mx, c[rr]);
            }
            st[t] = c;
        }
        mx = fmaxf(mx, shx(mx, 16, lane)); mx = fmaxf(mx, shx(mx, 32, lane));
        float den = 0.f;
#pragma unroll
        for (int t = 0; t < 9; ++t)
#pragma unroll
            for (int rr = 0; rr < 4; ++rr) { const float e = ex2(st[t][rr] - mx); st[t][rr] = e; den += e; }
        den += shx(den, 16, lane); den += shx(den, 32, lane);
        bf16x8 pf[5];
#pragma unroll
        for (int s = 0; s < 4; ++s) pf[s] = pack8(st[2 * s], st[2 * s + 1]);
        pf[4] = pack8(st[8], (f32x4){0.f, 0.f, 0.f, 0.f});
        const float inv = 1.f / den;
        bf16_t* O = (bf16_t*)(p->ws + WS_OBG) + ((size_t)g * TG + tokq) * 256 + head * 64;
#pragma unroll
        for (int dt = 0; dt < 4; ++dt) {
            f32x4 c = {0.f, 0.f, 0.f, 0.f};
#pragma unroll
            for (int s = 0; s < 5; ++s) {
                const int ra = (qt + 2 * s) * 16 + 4 * g4 + qq, rb = (qt + (s < 4 ? 2 * s + 1 : 8)) * 16 + 4 * g4 + qq;
                const int cha = dt * 2 + (pp >> 1), bo = (pp & 1) * 8;
                const s16x4 lo = trread(lds + DL_V + (hh * 192 + ra) * 128 + ((cha ^ (ra & 7)) * 16) + bo);
                const s16x4 hi = trread(lds + DL_V + (hh * 192 + rb) * 128 + ((cha ^ (rb & 7)) * 16) + bo);
                c = mfma16(cat8(lo, hi), pf[s], c);
            }
            u32x2 w; w.x = cvt_pk_bf16(c[0] * inv, c[1] * inv); w.y = cvt_pk_bf16(c[2] * inv, c[3] * inv);
            *(u32x2*)(O + dt * 16 + 4 * g4) = w;
        }
        if (g4 == 0) ((float*)(p->ws + WS_LSE))[((size_t)g * TG + tokq) * 4 + head] = (mx + log2f(den)) * LN2;
    }
}
DI void dil_phase(LAS unsigned char* lds, KP p, int c, int G, int N, int tid, int wave, int lane) {
    if (c >= N) return;
    u32x4 kr[6], vr[6];
    dil_load(p, c % 1536, tid, kr, vr);
    for (int it = c; it < N; it += G) {
        dil_store(lds, tid, kr, vr);
        __syncthreads();
        if (it + G < N) dil_load(p, (it + G) % 1536, tid, kr, vr);
        dil_compute(lds, p, it % 1536, tid, wave, lane);
        __syncthreads();
    }
}

DI void dil_merge(KP p, int G, int tid) {
    const float* LSE = (const float*)(p->ws + WS_LSE); const bf16_t* OBG = (const bf16_t*)(p->ws + WS_OBG);
    const bf16_t* Z = (const bf16_t*)(p->ws + WS_Z); bf16_t* OB = (bf16_t*)(p->ws + WS_OB);
    #pragma clang loop vectorize(disable) interleave(disable) unroll(disable)
    for (int e = blockIdx.x * 512 + tid; e < TG * 32; e += G * 512) {
        const int tok = e >> 5, c8 = (e & 31) * 8, head = c8 >> 6;
        const float l0 = LSE[(size_t)tok * 4 + head], l1 = LSE[((size_t)TG + tok) * 4 + head], l2 = LSE[((size_t)2 * TG + tok) * 4 + head];
        const float mx = fmaxf(l0, fmaxf(l1, l2)); float w0 = __expf(l0 - mx), w1 = __expf(l1 - mx), w2 = __expf(l2 - mx);
        const float inv = 1.f / (w0 + w1 + w2); w0 *= inv; w1 *= inv; w2 *= inv;
        const u32x4 a = *(const u32x4*)(OBG + (size_t)tok * 256 + c8), b = *(const u32x4*)(OBG + ((size_t)TG + tok) * 256 + c8), c = *(const u32x4*)(OBG + ((size_t)2 * TG + tok) * 256 + c8);
        const u32x4 z = *(const u32x4*)(Z + (size_t)tok * 1792 + 512 + c8);
        u32x4 o;
        o.x = cvt_pk_bf16((w0 * bflo(a.x) + w1 * bflo(b.x) + w2 * bflo(c.x)) * bflo(z.x), (w0 * bfhi(a.x) + w1 * bfhi(b.x) + w2 * bfhi(c.x)) * bfhi(z.x));
        o.y = cvt_pk_bf16((w0 * bflo(a.y) + w1 * bflo(b.y) + w2 * bflo(c.y)) * bflo(z.y), (w0 * bfhi(a.y) + w1 * bfhi(b.y) + w2 * bfhi(c.y)) * bfhi(z.y));
        o.z = cvt_pk_bf16((w0 * bflo(a.z) + w1 * bflo(b.z) + w2 * bflo(c.z)) * bflo(z.z), (w0 * bfhi(a.z) + w1 * bfhi(b.z) + w2 * bfhi(c.z)) * bfhi(z.z));
        o.w = cvt_pk_bf16((w0 * bflo(a.w) + w1 * bflo(b.w) + w2 * bflo(c.w)) * bflo(z.w), (w0 * bfhi(a.w) + w1 * bfhi(b.w) + w2 * bfhi(c.w)) * bfhi(z.w));
        *(u32x4*)(OB + (size_t)tok * 256 + c8) = o;
    }
}

DI void nat_load(const bf16_t* src, size_t tokbase, int hp, int tid, u32x4 (&rg)[16]) {
#pragma unroll
    for (int i = 0; i < 16; ++i) { const int c = tid + 512 * i, key = c >> 4, part = c & 15; rg[i] = *(const u32x4*)(src + (tokbase + key) * 512 + hp * 128 + part * 8); }
}
DI void nat_store(LAS unsigned char* lds, int tid, const u32x4 (&rg)[16]) {
#pragma unroll
    for (int i = 0; i < 16; ++i) { const int c = tid + 512 * i, key = c >> 4, part = c & 15, hh = part >> 3, piece = part & 7;
        *(LAS u32x4*)(lds + (hh * 512 + key) * 128 + ((piece ^ (key & 7)) * 16)) = rg[i]; }
}
DI size_t nat_tokbase(int item) { const int r = (item >> 2) & 63, bl = item >> 8; return (size_t)bl * SEQ + clampi(r - 4, 0, 56) * 64; }
DI void nat_phase(LAS unsigned char* lds, KP p, int l, int c, int G, int N, int tid, int wave, int lane) {
    if (c >= N) return;
    const bf16_t* CQ = (const bf16_t*)(p->ws + WS_CQ); const bf16_t* CK = (const bf16_t*)(p->ws + WS_CK); const bf16_t* CV = (const bf16_t*)(p->ws + WS_CV);
    u32x4 rg[16];
    nat_load(CK, nat_tokbase(c & 1023), c & 3, tid, rg);
    for (int it = c; it < N; it += G) {
        const int item = it & 1023, hp = item & 3, r = (item >> 2) & 63, bl = item >> 8;
        const int rs0 = clampi(r - 4, 0, 56);
        const size_t tokbase = (size_t)bl * SEQ + rs0 * 64;
        nat_store(lds, tid, rg);
        { LAS float* bl_ = (LAS float*)(lds + 131072 + 256); const float* rp_ = p->in[7] + (size_t)l * 3720 + hp * 930;
          bl_[tid] = rp_[tid]; if (tid < 930 - 512) bl_[tid + 512] = rp_[tid + 512]; }
        __syncthreads();
        nat_load(CV, tokbase, hp, tid, rg);
        int ln = lane; asm volatile("" : "+v"(ln));
        const int hh = wave >> 2, jb = wave & 3, i16 = ln & 15, g4 = ln >> 4, qq = i16 >> 2, pp = i16 & 3;
        const int h = hp * 2 + hh, qcol = 16 * jb + i16, kcs = clampi(16 * jb - 8, 0, 32), wst = clampi(qcol - 8, 0, 48);
        const size_t tokq = (size_t)bl * SEQ + r * 64 + qcol;
        bf16x8 pf[8]; float den = 0.f;
        {
            const bf16x8 qf0 = *(const bf16x8*)(CQ + tokq * 512 + h * 64 + 8 * g4), qf1 = *(const bf16x8*)(CQ + tokq * 512 + h * 64 + 32 + 8 * g4);
            const LAS float* rpb = (const LAS float*)(lds + 131072 + 256) + hh * 465;
            f32x4 st[16]; float mx = -1e30f;
#pragma unroll
            for (int t = 0; t < 16; ++t) {
                const int kr = t >> 1, ct = t & 1, row = kr * 64 + kcs + ct * 16 + i16;
                const LAS unsigned char* kp = lds + (hh * 512 + row) * 128;
                f32x4 cc = {0.f, 0.f, 0.f, 0.f};
                cc = mfma16(*(const LAS bf16x8*)(kp + ((g4 ^ (row & 7)) * 16)), qf0, cc);
                cc = mfma16(*(const LAS bf16x8*)(kp + (((4 + g4) ^ (row & 7)) * 16)), qf1, cc);
                const int ro = rs0 + kr - r + 7;
#pragma unroll
                for (int rr = 0; rr < 4; ++rr) {
                    const int kcol = kcs + ct * 16 + 4 * g4 + rr;
                    const bool ok = (kcol >= wst) && (kcol < wst + 16);
                    const int co = clampi(kcol - qcol + 15, 0, 30);
                    const float b = rpb[ro * 31 + co];
                    cc[rr] = ok ? (cc[rr] + b) * LOG2E : -1e30f; mx = fmaxf(mx, cc[rr]);
                }
                st[t] = cc;
                if ((t & 3) == 3) asm volatile("" ::: "memory");
            }
            mx = fmaxf(mx, shx(mx, 16, lane)); mx = fmaxf(mx, shx(mx, 32, lane));
#pragma unroll
            for (int t = 0; t < 16; ++t)
#pragma unroll
                for (int rr = 0; rr < 4; ++rr) { const float e = ex2(st[t][rr] - mx); st[t][rr] = e; den += e; }
            den += shx(den, 16, lane); den += shx(den, 32, lane);
#pragma unroll
            for (int kr = 0; kr < 8; ++kr) pf[kr] = pack8(st[2 * kr], st[2 * kr + 1]);
        }
        __syncthreads();
        nat_store(lds, tid, rg);
        __syncthreads();
        if (it + G < N) { const int nx = (it + G) & 1023; nat_load(CK, nat_tokbase(nx), nx & 3, tid, rg); }
        {
            const float inv = 1.f / den;
            const bf16_t* Z = (const bf16_t*)(p->ws + WS_Z) + tokq * 1792 + 768 + h * 64;
            bf16_t* OC = (bf16_t*)(p->ws + WS_OC) + tokq * 512 + h * 64;
#pragma unroll
            for (int dt = 0; dt < 4; ++dt) {
                f32x4 cc = {0.f, 0.f, 0.f, 0.f};
                const int cha = dt * 2 + (pp >> 1), bo = (pp & 1) * 8;
#pragma unroll
                for (int kr = 0; kr < 8; ++kr) {
                    const int ra = kr * 64 + kcs + 4 * g4 + qq, rb = ra + 16;
                    const s16x4 lo = trread(lds + (hh * 512 + ra) * 128 + ((cha ^ (ra & 7)) * 16) + bo);
                    const s16x4 hi = trread(lds + (hh * 512 + rb) * 128 + ((cha ^ (rb & 7)) * 16) + bo);
                    cc = mfma16(cat8(lo, hi), pf[kr], cc);
                }
                const int d = dt * 16 + 4 * g4; const u32x2 z = *(const u32x2*)(Z + d);
                u32x2 w; w.x = cvt_pk_bf16(cc[0] * inv * bflo(z.x), cc[1] * inv * bfhi(z.x)); w.y = cvt_pk_bf16(cc[2] * inv * bflo(z.y), cc[3] * inv * bfhi(z.y));
                *(u32x2*)(OC + d) = w;
            }
        }
        __syncthreads();
    }
}

constexpr int FA_K0 = 0, FA_K1 = 24576, FA_V0 = 49152, FA_V1 = 49152 + 16384;
DI void mla_unit(LAS unsigned char* lds, KP p, int unit, int tid, int wave, int lane_in) {
    int lane = lane_in; asm volatile("" : "+v"(lane));
    const int grp = (unit & 7) * 2 + ((unit >> 3) >> 4), qb = (unit >> 3) & 15, h = grp & 3, bl = grp >> 2;
    const bf16_t* MQ = (const bf16_t*)(p->ws + WS_MQ); const bf16_t* MK = (const bf16_t*)(p->ws + WS_MK) + (size_t)bl * SEQ * 768 + h * 192;
    const bf16_t* MV = (const bf16_t*)(p->ws + WS_MV) + (size_t)bl * SEQ * 512 + h * 128;
    const int i16 = lane & 15, g4 = lane >> 4, qq = i16 >> 2, pp = i16 & 3;
    const size_t q0 = (size_t)bl * SEQ + qb * 256 + wave * 32;
    bf16x8 qf[2][6];
#pragma unroll
    for (int qt = 0; qt < 2; ++qt)
#pragma unroll
        for (int ks = 0; ks < 6; ++ks) qf[qt][ks] = *(const bf16x8*)(MQ + (q0 + qt * 16 + i16) * 768 + h * 192 + ks * 32 + 8 * g4);
    float mrun[2] = {-1e30f, -1e30f}, lrun[2] = {0.f, 0.f};
    f32x4 o[8][2];
#pragma unroll
    for (int dt = 0; dt < 8; ++dt) { o[dt][0] = (f32x4){0.f, 0.f, 0.f, 0.f}; o[dt][1] = (f32x4){0.f, 0.f, 0.f, 0.f}; }
    unsigned kgo[3], vgo[2];
#pragma unroll
    for (int i = 0; i < 3; ++i) { const int pidx = (wave * 3 + i) * 64 + lane, row = pidx / 24, cs = pidx % 24; kgo[i] = (unsigned)(row * 768 + ((cs ^ (row & 7)) * 8)) * 2u; }
#pragma unroll
    for (int i = 0; i < 2; ++i) { const int pidx = (wave * 2 + i) * 64 + lane, row = pidx >> 4, cs = pidx & 15; vgo[i] = (unsigned)(row * 512 + ((cs ^ (2 * (row & 7))) * 8)) * 2u; }
#define FA_STAGE(tile, kbo, vbo) do { const char* gk_ = (const char*)(MK + (size_t)(tile) * 64 * 768); const char* gv_ = (const char*)(MV + (size_t)(tile) * 64 * 512); \
        _Pragma("unroll") for (int i = 0; i < 3; ++i) __builtin_amdgcn_global_load_lds((const unsigned*)(gk_ + kgo[i]), (LAS unsigned*)(lds + (kbo) + (wave * 3 + i) * 1024), 16, 0, 0); \
        _Pragma("unroll") for (int i = 0; i < 2; ++i) __builtin_amdgcn_global_load_lds((const unsigned*)(gv_ + vgo[i]), (LAS unsigned*)(lds + (vbo) + (wave * 2 + i) * 1024), 16, 0, 0); } while (0)
    FA_STAGE(0, FA_K0, FA_V0);
    asm volatile("s_waitcnt vmcnt(0)" ::: "memory");
    __syncthreads();
    const int s7 = i16 & 7;
    for (int t = 0; t < 64; ++t) {
        const int cur = t & 1;
        const LAS unsigned char* kb = lds + (cur ? FA_K1 : FA_K0); LAS unsigned char* vb = lds + (cur ? FA_V1 : FA_V0);
        if (t + 1 < 64) FA_STAGE(t + 1, cur ? FA_K0 : FA_K1, cur ? FA_V0 : FA_V1);
        f32x4 st[4][2];
#pragma unroll
        for (int kt = 0; kt < 4; ++kt) { st[kt][0] = (f32x4){0.f, 0.f, 0.f, 0.f}; st[kt][1] = (f32x4){0.f, 0.f, 0.f, 0.f}; }
        {
            bf16x8 kfr[3][2];
#define FA_KLOAD(slot, jj) do { const int ks_ = (jj) >> 1, kh_ = (jj) & 1; _Pragma("unroll") for (int e = 0; e < 2; ++e) \
                kfr[slot][e] = *(const LAS bf16x8*)(kb + ((2 * kh_ + e) * 16 + i16) * 384 + (((ks_ * 4 + g4) ^ s7) * 16)); } while (0)
            FA_KLOAD(0, 0); FA_KLOAD(1, 1);
#pragma unroll
            for (int j = 0; j < 12; ++j) {
                const int ks = j >> 1, kh = j & 1;
                if (j + 2 < 12) FA_KLOAD((j + 2) % 3, j + 2);
                __builtin_amdgcn_sched_barrier(0);
#pragma unroll
                for (int e = 0; e < 2; ++e) { const int kt = 2 * kh + e; st[kt][0] = mfma16(kfr[j % 3][e], qf[0][ks], st[kt][0]); st[kt][1] = mfma16(kfr[j % 3][e], qf[1][ks], st[kt][1]); }
                __builtin_amdgcn_sched_barrier(0);
            }
#undef FA_KLOAD
        }
        bf16x8 pf[2][2];
#pragma unroll
        for (int qt = 0; qt < 2; ++qt) {
            float mx = -1e30f;
#pragma unroll
            for (int kt = 0; kt < 4; ++kt)
#pragma unroll
                for (int r = 0; r < 4; ++r) mx = fmaxf(mx, st[kt][qt][r]);
            mx = fmaxf(mx, shx(mx, 16, lane)); mx = fmaxf(mx, shx(mx, 32, lane));
            const float mn = fmaxf(mrun[qt], mx), alpha = ex2(mrun[qt] - mn); mrun[qt] = mn;
            float ps = 0.f;
#pragma unroll
            for (int kt = 0; kt < 4; ++kt)
#pragma unroll
                for (int r = 0; r < 4; ++r) { const float e = ex2(st[kt][qt][r] - mn); st[kt][qt][r] = e; ps += e; }
            lrun[qt] = lrun[qt] * alpha + ps;
            if (__builtin_amdgcn_ballot_w64(alpha != 1.0f) != 0ull) {
#pragma unroll
                for (int dt = 0; dt < 8; ++dt) o[dt][qt] *= alpha;
            }
            pf[qt][0] = pack8(st[0][qt], st[1][qt]); pf[qt][1] = pack8(st[2][qt], st[3][qt]);
        }
        const int vrow = 4 * g4 + qq, vsw = 2 * (vrow & 7);
        {
            bf16x8 vfr[3];
            const int cb = (pp & 1) * 8, ch0 = (pp >> 1);
#define FA_VLOAD(slot, jj) do { const int dt_ = (jj) >> 1, s2_ = (jj) & 1, ra_ = (2 * s2_) * 16 + vrow, co_ = (((dt_ * 2 + ch0) ^ vsw) * 16) + cb; \
                vfr[slot] = cat8(trread(vb + ra_ * 256 + co_), trread(vb + (ra_ + 16) * 256 + co_)); } while (0)
            FA_VLOAD(0, 0); FA_VLOAD(1, 1);
#pragma unroll
            for (int j = 0; j < 16; ++j) {
                const int dt = j >> 1, s2 = j & 1;
                if (j + 2 < 16) FA_VLOAD((j + 2) % 3, j + 2);
                __builtin_amdgcn_sched_barrier(0);
                o[dt][0] = mfma16(vfr[j % 3], pf[0][s2], o[dt][0]); o[dt][1] = mfma16(vfr[j % 3], pf[1][s2], o[dt][1]);
                __builtin_amdgcn_sched_barrier(0);
            }
#undef FA_VLOAD
        }
        asm volatile("s_waitcnt vmcnt(0)" ::: "memory");
        __syncthreads();
    }
#undef FA_STAGE
#pragma unroll
    for (int qt = 0; qt < 2; ++qt) {
        float lt = lrun[qt]; lt += shx(lt, 16, lane); lt += shx(lt, 32, lane);
        const float inv = 1.f / lt;
        const size_t tok = q0 + qt * 16 + i16;
        const bf16_t* Z = (const bf16_t*)(p->ws + WS_Z) + tok * 1792 + h * 128;
        bf16_t* OA = (bf16_t*)(p->ws + WS_OA) + tok * 512 + h * 128;
#pragma unroll
        for (int dt = 0; dt < 8; ++dt) {
            const int d = dt * 16 + 4 * g4; const u32x2 z = *(const u32x2*)(Z + d); const f32x4 c = o[dt][qt];
            u32x2 w; w.x = cvt_pk_bf16(c[0] * inv * bflo(z.x), c[1] * inv * bfhi(z.x)); w.y = cvt_pk_bf16(c[2] * inv * bflo(z.y), c[3] * inv * bfhi(z.y));
            *(u32x2*)(OA + d) = w;
        }
    }
}

#define XB_TMO      128
#define XB_XCNT(j)  (256  + 64 * (j))
#define XB_XSUB(j)  (1280 + 64 * (j))
#define XB_XGEN(j)  (2304 + 64 * (j))
#define XB_TOP      3328
#define XB_TOPGEN   3392
#define XCD_BAR_WORDS 3456
#define XB_SPIN_CAP (1u << 20)
DI unsigned xb_ld(unsigned* p) { return __hip_atomic_load(p, __ATOMIC_RELAXED, __HIP_MEMORY_SCOPE_AGENT); }
DI unsigned xb_add(unsigned* p, unsigned v) { return __hip_atomic_fetch_add(p, v, __ATOMIC_RELAXED, __HIP_MEMORY_SCOPE_AGENT); }
DI unsigned xb_xcc_id() { return (unsigned)__builtin_amdgcn_s_getreg((3 << 11) | 20) & 0xFu; }
#define XB_SPIN(cond, bar) do { unsigned _sp = 0; while (cond) { __builtin_amdgcn_s_sleep(1); \
    if ((++_sp & 255u) == 0u) { if (xb_ld(&(bar)[XB_TMO])) break; if (_sp > XB_SPIN_CAP) { atomicAdd(&(bar)[XB_TMO], 1u); break; } } } } while (0)
DI void xcd_barrier_complete(unsigned* bar, unsigned x, unsigned& nloc, unsigned& nx) {
    const unsigned G = gridDim.x;
    unsigned sum, cnt, mine, sp = 0u;
    for (;;) {
        sum = 0u; cnt = 0u; mine = 0u;
#pragma unroll
        for (unsigned j = 0; j < 16; ++j) { const unsigned c = xb_ld(&bar[XB_XCNT(j)]); sum += c; cnt += (c > 0u) ? 1u : 0u; mine = (j == x) ? c : mine; }
        if (sum == G) break;
        __builtin_amdgcn_s_sleep(1);
        if ((++sp & 255u) == 0u) { if (xb_ld(&bar[XB_TMO])) break; if (sp > XB_SPIN_CAP) { atomicAdd(&bar[XB_TMO], 1u); break; } }
    }
    nloc = mine > 0u ? mine : 1u; nx = cnt > 0u ? cnt : 1u;
}
DI void xcd_barrier(unsigned* bar, volatile LAS unsigned* st, int tid) {
    asm volatile("s_waitcnt vmcnt(0)" ::: "memory");
    __syncthreads();
    if (tid == 0) {
        __builtin_amdgcn_s_waitcnt(0);
        const unsigned x = xb_xcc_id();
        unsigned nloc = st[0], nx = st[1];
        if (nloc == 0u) { xcd_barrier_complete(bar, x, nloc, nx); st[0] = nloc; st[1] = nx; }
        const unsigned old = xb_add(&bar[XB_XSUB(x)], 1u);
        const unsigned gen = old / nloc;
        if (old + 1u == (gen + 1u) * nloc) {
            __builtin_amdgcn_fence(__ATOMIC_RELEASE, "agent");
            asm volatile("s_waitcnt vmcnt(0)" ::: "memory");
            const unsigned og = xb_add(&bar[XB_TOP], 1u);
            const unsigned tg = og / nx;
            if (og + 1u == (tg + 1u) * nx) xb_add(&bar[XB_TOPGEN], 1u);
            else XB_SPIN(xb_ld(&bar[XB_TOPGEN]) == tg, bar);
            __builtin_amdgcn_fence(__ATOMIC_ACQUIRE, "agent");
            xb_add(&bar[XB_XGEN(x)], 1u);
            asm volatile("s_waitcnt vmcnt(0)" ::: "memory");
        } else {
            XB_SPIN(xb_ld(&bar[XB_XGEN(x)]) == gen, bar);
            __builtin_amdgcn_fence(__ATOMIC_ACQUIRE, "agent");
            asm volatile("s_waitcnt vmcnt(0)" ::: "memory");
        }
    }
    __syncthreads();
}

__global__ void __launch_bounds__(512, 2) mega_fwd(Params pk) {
    extern __shared__ __attribute__((aligned(16))) unsigned char lds_raw[];
    LAS unsigned char* lds = (LAS unsigned char*)lds_raw;
    cg::grid_group grid = cg::this_grid();
    const int G = gridDim.x, c = blockIdx.x;
    const int wave_s = __builtin_amdgcn_readfirstlane((int)threadIdx.x >> 6);
    unsigned* bar = (unsigned*)(pk.ws + WS_BAR);
    volatile LAS unsigned* bst = (volatile LAS unsigned*)(lds + 131072);
    if (threadIdx.x < 2) bst[threadIdx.x] = 0u;
    if (blockIdx.x == 0) for (int i = threadIdx.x; i < XCD_BAR_WORDS; i += 512) __hip_atomic_store(bar + i, 0u, __ATOMIC_RELAXED, __HIP_MEMORY_SCOPE_AGENT);
    __syncthreads();
    for (int ph = pk.ph_lo; ph < pk.ph_hi; ++ph) {
        unsigned zero_ = 0u; asm volatile("" : "+s"(zero_));
        int tid = wave_s * 64 + (int)__builtin_amdgcn_mbcnt_hi(~0u, __builtin_amdgcn_mbcnt_lo(~0u, zero_)); asm volatile("" : "+v"(tid));
        if (ph > pk.ph_lo) {
            if (ph == pk.ph_lo + 1) {
                grid.sync();
                if (tid == 0) (void)xb_add(&bar[XB_XCNT(xb_xcc_id())], 1u);
            } else xcd_barrier(bar, bst, tid);
        }
        KP p = (KP)__builtin_amdgcn_kernarg_segment_ptr(); asm volatile("" : "+s"(p));
        unsigned char* ws = p->ws;
        const int lane = tid & 63, wave = __builtin_amdgcn_readfirstlane(tid >> 6);
#ifndef PHM
#define PHM 0xffff
#endif
#ifndef REPM
#define REPM 0
#endif
#ifndef REPN
#define REPN 2
#endif
#define NREP(bit) (((REPM) & (bit)) ? (REPN) : 1)
        if (ph == 0) { if (PHM & 1) phase_prep(p, lds, tid, wave, lane, G);
            phase_rms(p->in[0], p->in[1], (bf16_t*)(ws + WS_H), (float*)(ws + WS_SSQ), tid, wave, lane, G); continue; }
        if (ph == NPH - 1) { if (PHM & 2) phase_final(p->out, p->in[20], wave, lane, G); continue; }
        const int q = ph - 1, idx = q / 6, l = idx >> 1, gi = idx & 1, sp = q % 6 + 1;
        unsigned char* wb = ws + WS_W + l * W_LSTRIDE;
        const float* xin = (l == 0 ? p->in[0] : (const float*)p->out) + (size_t)gi * TG * DM;
        float* xout = p->out + (size_t)gi * TG * DM;
        if (sp == 0) {
        } else if (sp == 1) {
            pg8::SchedStd S; S.init(ws + WS_H, wb + W_1T, TG, 7168, 1024, G, c, NREP(8));
            EpiIn E{ws};
            if (PHM & 8) pg8::gemm_phase(lds, S, E, tid);
        } else if (sp == 2) {
            { pg8::SchedUp S{(const char*)ws, (const char*)wb, G, c, NREP(16)};
              EpiUp E{ws};
              if (PHM & 16) pg8::gemm_phase(lds, S, E, tid); }
            if (PHM & 32) for (int it = c; it < 1024 * NREP(32); it += G) gla_g1_item(lds, p, l, it & 1023, tid, wave, lane);
        } else if (sp == 3) {
            if (PHM & 64) dil_phase(lds, p, c, G, 1536 * NREP(64), tid, wave, lane);
            if (PHM & 128) nat_phase(lds, p, l, c, G, 1024 * NREP(128), tid, wave, lane);
            if (PHM & 256) gla_scan(p, G, tid);
        } else if (sp == 4) {
            if (PHM & 512) for (int u = c; u < 256 * NREP(512); u += G) mla_unit(lds, p, u & 255, tid, wave, lane);
            __syncthreads();
            if (PHM & 1024) for (int it = c; it < 1024 * NREP(1024); it += G) gla_g3_item(lds, p, l, it & 1023, tid, wave, lane);
            if (PHM & 2048) dil_merge(p, G, tid);
        } else if (sp == 5) {
            pg8::SchedMix S{(const char*)ws, (const char*)wb, G, c, NREP(4096)};
            EpiMix E{ws, p->in[18] + l * 4096};
            if (PHM & 4096) pg8::gemm_phase<EpiMix, pg8::SchedMix, MixState>(lds, S, E, tid);
        } else {
            pg8::SchedStd S; S.init(ws + WS_MIXED, wb + W_OUT, TG, 1024, 1024, G, c, NREP(8192));
            EpiOut E{xin, xout};
            if (PHM & 8192) pg8::gemm_phase(lds, S, E, tid);
            if (idx < 3) {
                const int nl = (idx + 1) >> 1, ng = (idx + 1) & 1;
                phase_rms((nl == 0 ? p->in[0] : (const float*)p->out) + (size_t)ng * TG * DM, p->in[1] + nl * DM, (bf16_t*)(ws + WS_H), (float*)(ws + WS_SSQ), tid, wave, lane, G);
            }
        }
    }
}

#ifndef MK_MULTI
#define MK_MULTI 0
#endif
extern "C" void kernel_launch(void* const* d_in, const int* in_sizes, int n_in, void* d_out, int out_size, void* d_ws, size_t ws_size, hipStream_t stream) {
    static int grid = 0;
    if (grid == 0) {
        if (n_in != 21 || ws_size < WS_END) { fprintf(stderr, "kernel_launch: unexpected n_in %d or ws_size %zu (< %zu)\n", n_in, ws_size, (size_t)WS_END); grid = -1; return; }
        int dev = 0, cus = 0, per_cu = 0;
        hipGetDevice(&dev);
        hipDeviceGetAttribute(&cus, hipDeviceAttributeMultiprocessorCount, dev);
        hipFuncSetAttribute((const void*)mega_fwd, hipFuncAttributeMaxDynamicSharedMemorySize, LDS_BYTES);
        hipOccupancyMaxActiveBlocksPerMultiprocessor(&per_cu, (const void*)mega_fwd, 512, LDS_BYTES);
        if (per_cu < 1) { fprintf(stderr, "kernel_launch: occupancy query returned %d\n", per_cu); per_cu = 1; }
        (void)hipGetLastError();
        grid = cus * per_cu;
        if (grid > 256) grid = 256;
    }
    if (grid < 0) return;
    Params p{};
    for (int i = 0; i < 21; ++i) p.in[i] = (const float*)d_in[i];
    p.out = (float*)d_out; p.ws = (unsigned char*)d_ws;
#if MK_MULTI
    for (int ph = 0; ph < NPH; ++ph) {
        p.ph_lo = ph; p.ph_hi = ph + 1;
        hipLaunchKernelGGL(mega_fwd, dim3(grid), dim3(512), LDS_BYTES, stream, p);
    }
#else
    p.ph_lo = 0; p.ph_hi = NPH;
    void* args[] = {&p};
    hipError_t e = hipLaunchCooperativeKernel((const void*)mega_fwd, dim3(grid), dim3(512), args, LDS_BYTES, stream);
    if (e != hipSuccess) fprintf(stderr, "cooperative launch failed: %s (grid %d)\n", hipGetErrorString(e), grid);
#endif
}
```

```cpp
#include <hip/hip_runtime.h>
#include <hip/hip_cooperative_groups.h>
#include <cstdio>
#include <cstdint>
namespace cg = cooperative_groups;

#define LAS __attribute__((address_space(3)))
#define DI __device__ __forceinline__
typedef unsigned short bf16_t;
typedef short bf16x8 __attribute__((ext_vector_type(8)));
typedef short s16x4 __attribute__((ext_vector_type(4)));
typedef float f32x4 __attribute__((ext_vector_type(4)));
typedef unsigned u32x4 __attribute__((ext_vector_type(4)));
typedef unsigned u32x2 __attribute__((ext_vector_type(2)));
typedef _Float16 h16x8 __attribute__((ext_vector_type(8)));
typedef float f32x8 __attribute__((ext_vector_type(8)));

constexpr int SEQ = 4096, DM = 1024, TG = 16384, NGRP = 2, DIN = 7136;
constexpr float EPS = 1e-6f, LOG2E = 1.4426950408889634f, LN2 = 0.6931471805599453f;
constexpr float QSCALE = 0.07216878364870322f * 1.4426950408889634f;
constexpr int NPH = 26;

constexpr size_t MiB = 1u << 20;
constexpr size_t WS_ROPEC = 0, WS_ROPES = MiB / 2;
constexpr size_t WS_SSQ = 1 * MiB, WS_LSE = 1 * MiB + 256 * 1024;
constexpr size_t WS_DEC = 2 * MiB, WS_GFB = 3 * MiB, WS_BAR = 5 * MiB;
constexpr size_t WS_W = 6 * MiB, W_LSTRIDE = 30 * MiB;
constexpr size_t W_1T = 0, W_GT = 14 * MiB, W_UP = 22 * MiB, W_PA = 24 * MiB, W_PB = 25 * MiB, W_PC = 25 * MiB + MiB / 2, W_PD = 26 * MiB + MiB / 2, W_OUT = 27 * MiB + MiB / 2;
constexpr size_t WS_H = 66 * MiB, WS_LAT = 98 * MiB, WS_Z = 110 * MiB;
constexpr size_t WS_OA = 166 * MiB, WS_OB = 182 * MiB, WS_OC = 190 * MiB, WS_OD = 206 * MiB;
constexpr size_t WS_BQKV = 222 * MiB, WS_MIXED = 222 * MiB;
constexpr size_t WS_CQ = 294 * MiB, WS_CK = 310 * MiB, WS_CV = 326 * MiB;
constexpr size_t WS_SCRG = 294 * MiB, WS_MIXACC = 326 * MiB;
constexpr size_t WS_DQ = 342 * MiB, WS_DK = 350 * MiB, WS_DV = 358 * MiB;
constexpr size_t WS_MQ = 374 * MiB, WS_MK = 398 * MiB, WS_MV = 422 * MiB;
constexpr size_t WS_KV = 438 * MiB, WS_OBG = 470 * MiB, WS_LAC = 494 * MiB, WS_END = 510 * MiB;
constexpr int LDS_BYTES = 131072 + 256 + 3840;
static_assert(WS_OB == WS_OA + 16 * MiB && WS_OC == WS_OA + 24 * MiB && WS_OD == WS_OA + 40 * MiB, "O map");
static_assert(W_PB == W_PA + MiB && W_PC == W_PA + MiB + MiB / 2 && W_PD == W_PA + 2 * MiB + MiB / 2, "Wp map");

typedef float f32x2 __attribute__((ext_vector_type(2)));
typedef __bf16 bf16x2_t __attribute__((ext_vector_type(2)));
DI unsigned cvt_pk_bf16(float lo, float hi) { const f32x2 f = {lo, hi}; const bf16x2_t v = __builtin_convertvector(f, bf16x2_t); return __builtin_bit_cast(unsigned, v); }
DI float bf2f(unsigned short h) { return __uint_as_float(((unsigned)h) << 16); }
DI float bflo(unsigned w) { return __uint_as_float(w << 16); }
DI float bfhi(unsigned w) { return __uint_as_float(w & 0xffff0000u); }
DI f32x4 mfma16(bf16x8 a, bf16x8 b, f32x4 c) { return __builtin_amdgcn_mfma_f32_16x16x32_bf16(a, b, c, 0, 0, 0); }
DI s16x4 trread(LAS unsigned char* p) { return __builtin_amdgcn_ds_read_tr16_b64_v4i16((LAS s16x4*)p); }
DI bf16x8 cat8(s16x4 lo, s16x4 hi) { return __builtin_shufflevector(lo, hi, 0, 1, 2, 3, 4, 5, 6, 7); }
DI bf16x8 pack8(f32x4 a, f32x4 b) { u32x4 w; w.x = cvt_pk_bf16(a[0], a[1]); w.y = cvt_pk_bf16(a[2], a[3]); w.z = cvt_pk_bf16(b[0], b[1]); w.w = cvt_pk_bf16(b[2], b[3]); return __builtin_bit_cast(bf16x8, w); }
DI float ex2(float x) { return __builtin_amdgcn_exp2f(x); }
DI float siluf(float x) { return x * __builtin_amdgcn_rcpf(1.0f + __builtin_amdgcn_exp2f(-1.4426950408889634f * x)); }
DI float sigmf(float x) { return __builtin_amdgcn_rcpf(1.0f + __builtin_amdgcn_exp2f(-1.4426950408889634f * x)); }
DI float shx(float v, int mask, int lane) { return __int_as_float(__builtin_amdgcn_ds_bpermute((lane ^ mask) << 2, __float_as_int(v))); }
DI float wave_sum(float v, int lane) {
#pragma unroll
    for (int o = 1; o < 64; o <<= 1) v += shx(v, o, lane);
    return v;
}
DI int clampi(int v, int lo, int hi) { return v < lo ? lo : (v > hi ? hi : v); }
DI int perm32(int p) { return 8 * ((p >> 2) & 3) + 4 * ((p >> 4) & 1) + (p & 3); }
DI int pcol(int c) { return (c & ~31) | perm32(c & 31); }
DI int rope_perm(int p) { return 32 * ((p >> 4) & 1) + 16 * ((p >> 5) & 1) + (p & 15); }

namespace pg8 {
constexpr int BM = 256, BK = 64, HALF = 128, HTB = HALF * BK * 2, NXCD = 8, WGM = 8;
DI int lds_byte(int r, int c) { const int st = (r >> 4) * 2 + (c >> 5), rr = r & 15, cc = c & 31, ob = rr * 64 + cc * 2; return st * 1024 + (ob ^ (((ob >> 9) & 1) << 5)); }
DI void stage_rc(int b, int& R, int& C) { const int st = b / 1024, sb = b % 1024, swz = sb ^ (((sb >> 9) & 1) << 5); R = (st >> 1) * 16 + swz / 64; C = (st & 1) * 32 + (swz % 64) / 2; }

struct Unit { const char* A; const char* B; int K; int pm, pn, tag; };

struct NoState {};
template <class Epi, class Sched, class State = NoState>
DI void gemm_phase(LAS unsigned char* lds, const Sched& S, const Epi& E, int tid) {
    State est;
    const int wid = __builtin_amdgcn_readfirstlane(tid >> 6), lane = tid & 63, wr = wid >> 2, wc = wid & 3, fr = lane & 15, fq = lane >> 4;
    int R0, C0; stage_rc(tid * 16, R0, C0);
    const size_t kstep = (size_t)(BK * 2);
    const unsigned ldsw = (unsigned)wid * 1024u;
    const int aoff = lds_byte(wr * 64 + fr, fq * 8), boff = lds_byte(wc * 32 + fr, fq * 8);
#define PG8_SA(b, h) (((b) * 2 + (h)) * HTB)
#define PG8_SB(b, h) ((4 + (b) * 2 + (h)) * HTB)
#define PG8_STAGE(bufoff, gbase, v0, qs) do { \
        __builtin_amdgcn_global_load_lds((const unsigned*)((const char*)(gbase) + (v0)), (LAS unsigned*)(lds + (bufoff) + ldsw), 16, 0, 0); \
        __builtin_amdgcn_global_load_lds((const unsigned*)((const char*)(gbase) + (qs) + (v0)), (LAS unsigned*)(lds + (bufoff) + ldsw + 8192), 16, 0, 0); } while (0)
#define PG8_LDA(dst, b, h) do { _Pragma("unroll") for (int m = 0; m < 4; ++m) _Pragma("unroll") for (int k = 0; k < 2; ++k) dst[m][k] = *(const LAS bf16x8*)(lds + PG8_SA(b, h) + aoff + m * 2048 + k * 1024); } while (0)
#define PG8_LDB(dst, b, h) do { _Pragma("unroll") for (int n = 0; n < 2; ++n) _Pragma("unroll") for (int k = 0; k < 2; ++k) dst[n][k] = *(const LAS bf16x8*)(lds + PG8_SB(b, h) + boff + n * 2048 + k * 1024); } while (0)
#define PG8_MMA(ai, bj, At, Bt) do { __builtin_amdgcn_s_setprio(1); _Pragma("unroll") for (int m = 0; m < 4; ++m) _Pragma("unroll") for (int n = 0; n < 2; ++n) _Pragma("unroll") for (int k = 0; k < 2; ++k) \
        acc[ai][bj][m][n] = __builtin_amdgcn_mfma_f32_16x16x32_bf16(Bt[n][k], At[m][k], acc[ai][bj][m][n], 0, 0, 0); __builtin_amdgcn_s_setprio(0); } while (0)
#define PG8_WAIT_V(n) asm volatile("s_waitcnt vmcnt(" #n ")" ::: "memory")
#define PG8_WAIT_L(n) asm volatile("s_waitcnt lgkmcnt(" #n ")" ::: "memory")
#define PG8_BAR __builtin_amdgcn_s_barrier()
#define PG8_SCHED __builtin_amdgcn_sched_barrier(0)
    Unit cur, nxt; int ui = 0;
    if (!S.next(0, cur)) return;
    f32x4 acc[2][2][4][2];
#pragma unroll
    for (int a = 0; a < 2; ++a)
#pragma unroll
        for (int b = 0; b < 2; ++b)
#pragma unroll
            for (int m = 0; m < 4; ++m)
#pragma unroll
                for (int n = 0; n < 2; ++n) acc[a][b][m][n] = (f32x4){0.f, 0.f, 0.f, 0.f};
    bf16x8 At[4][2], B0[2][2], B1[2][2];
    const char* cA = cur.A; const char* cB = cur.B; int cK = cur.K;
    unsigned cv0 = (unsigned)(R0 * cK + C0) * 2u; size_t chs = (size_t)HALF * cK * 2, cv1 = chs >> 1;
    PG8_STAGE(PG8_SB(0, 0), cB, cv0, cv1); PG8_STAGE(PG8_SB(0, 1), cB + chs, cv0, cv1); PG8_STAGE(PG8_SA(0, 0), cA, cv0, cv1); PG8_STAGE(PG8_SA(0, 1), cA + chs, cv0, cv1);
    if (wr == 1) PG8_BAR;
    PG8_WAIT_V(2); PG8_BAR;
    PG8_STAGE(PG8_SB(1, 0), cB + kstep, cv0, cv1); PG8_STAGE(PG8_SA(1, 0), cA + kstep, cv0, cv1); PG8_STAGE(PG8_SB(1, 1), cB + chs + kstep, cv0, cv1);
    PG8_WAIT_V(6); PG8_BAR;
    for (;;) {
        const bool has_next = S.next(ui + 1, nxt);
        const char* nA = has_next ? nxt.A : cA; const char* nB = has_next ? nxt.B : cB; const int nK = has_next ? nxt.K : cK;
        unsigned nv0; { int t2 = tid; asm volatile("" : "+v"(t2)); int R2, C2; stage_rc(t2 * 16, R2, C2); nv0 = (unsigned)(R2 * nK + C2) * 2u; }
        const size_t nhs = (size_t)HALF * nK * 2, nv1 = nhs >> 1;
        const int nt = cK / BK;
        for (int t = 0; t < nt; t += 2) {
            const bool last = (t == nt - 2);
            const char* a1 = cA + (size_t)(t + 1) * kstep;
            const char* a2 = last ? nA : cA + (size_t)(t + 2) * kstep; const char* b2 = last ? nB : cB + (size_t)(t + 2) * kstep;
            const char* a3 = a2 + kstep; const char* b3 = b2 + kstep;
            const unsigned w0 = last ? nv0 : cv0; const size_t hs2 = last ? nhs : chs, w1 = hs2 >> 1;
            PG8_LDB(B0, 0, 0); PG8_LDB(B1, 0, 1); PG8_SCHED; PG8_LDA(At, 0, 0); PG8_STAGE(PG8_SA(1, 1), a1 + chs, cv0, cv1);
            PG8_WAIT_V(8); PG8_WAIT_L(0); PG8_BAR; PG8_MMA(0, 0, At, B0); PG8_MMA(0, 1, At, B1); PG8_BAR; PG8_SCHED;
            PG8_LDA(At, 0, 1); PG8_STAGE(PG8_SB(0, 0), b2, w0, w1); PG8_STAGE(PG8_SB(0, 1), b2 + hs2, w0, w1); PG8_STAGE(PG8_SA(0, 0), a2, w0, w1);
            PG8_WAIT_V(8); PG8_WAIT_L(0); PG8_BAR; PG8_MMA(1, 0, At, B0); PG8_MMA(1, 1, At, B1); PG8_BAR; PG8_SCHED;
            PG8_LDB(B0, 1, 0); PG8_LDB(B1, 1, 1); PG8_SCHED; PG8_LDA(At, 1, 0); PG8_STAGE(PG8_SA(0, 1), a2 + hs2, w0, w1);
            PG8_WAIT_V(8); PG8_WAIT_L(0); PG8_BAR; PG8_MMA(0, 0, At, B0); PG8_MMA(0, 1, At, B1); PG8_BAR; PG8_SCHED;
            PG8_LDA(At, 1, 1); PG8_STAGE(PG8_SB(1, 0), b3, w0, w1); PG8_STAGE(PG8_SB(1, 1), b3 + hs2, w0, w1); PG8_STAGE(PG8_SA(1, 0), a3, w0, w1);
            PG8_WAIT_V(8); PG8_WAIT_L(0); PG8_BAR; PG8_MMA(1, 0, At, B0); PG8_MMA(1, 1, At, B1); PG8_BAR; PG8_SCHED;
        }
        if (wr == 0) PG8_BAR;
        { int efr = fr, efq = fq; asm volatile("" : "+v"(efr), "+v"(efq)); E(acc, cur, wr, wc, efr, efq, est); }
        if (!has_next) break;
#pragma unroll
        for (int a = 0; a < 2; ++a)
#pragma unroll
            for (int b = 0; b < 2; ++b)
#pragma unroll
                for (int m = 0; m < 4; ++m)
#pragma unroll
                    for (int n = 0; n < 2; ++n) acc[a][b][m][n] = (f32x4){0.f, 0.f, 0.f, 0.f};
        cur = nxt; cA = nA; cB = nB; cK = nK; cv0 = nv0; cv1 = nv1; chs = nhs; ++ui;
        if (wr == 1) PG8_BAR;
    }
    PG8_WAIT_V(0);
    PG8_BAR;
#undef PG8_SA
#undef PG8_SB
#undef PG8_STAGE
#undef PG8_LDA
#undef PG8_LDB
#undef PG8_MMA
#undef PG8_WAIT_V
#undef PG8_WAIT_L
#undef PG8_BAR
#undef PG8_SCHED
}

struct SchedStd {
    const char* A; const char* B; int K, nM, nN, nwg, G, c, rep;
    DI void init(const void* A_, const void* B_, int M, int N, int K_, int G_, int c_, int rep_ = 1) { A = (const char*)A_; B = (const char*)B_; K = K_; nM = M / BM; nN = N / BM; nwg = nM * nN; G = G_; c = c_; rep = rep_; }
    DI bool next(int i, Unit& u) const {
        const long L0 = (long)i * G + c; if (L0 >= (long)nwg * rep) return false;
        int wgid = (int)(L0 % nwg); const int tg = (L0 >= nwg) ? 1 : 0; { const int q = nwg / NXCD, r = nwg % NXCD, xcd = wgid % NXCD, off = wgid / NXCD; wgid = (xcd < r ? xcd * (q + 1) : r * (q + 1) + (xcd - r) * q) + off; }
        const int nig = WGM * nN, gid = wgid / nig, fm = gid * WGM, gsz = (nM - fm) < WGM ? (nM - fm) : WGM;
        u.pm = fm + ((wgid % nig) % gsz); u.pn = (wgid % nig) / gsz; u.K = K; u.tag = tg;
        u.A = A + (size_t)u.pm * BM * K * 2; u.B = B + (size_t)u.pn * BM * K * 2; return true;
    }
};
struct SchedUp {
    const char* ws; const char* wb; int G, c, rep;
    DI bool next(int i, Unit& u) const {
        const int nwg = 448; const long L0 = (long)i * G + c; if (L0 >= (long)nwg * rep) return false;
        int wgid = (int)(L0 % nwg); u.tag = (L0 >= nwg) ? 1 : 0;
        { const int q = nwg / NXCD, xcd = wgid % NXCD, off = wgid / NXCD; wgid = xcd * q + off; }
        const int nig = WGM * 7, gid = wgid / nig, fm = gid * WGM;
        u.pm = fm + ((wgid % nig) % WGM); u.pn = (wgid % nig) / WGM;
        if (u.pn < 3) { u.K = 256; u.A = ws + WS_LAT + (size_t)u.pm * BM * 256 * 2; u.B = wb + W_UP + (size_t)u.pn * BM * 256 * 2; }
        else { u.K = 128; u.A = ws + WS_LAT + (size_t)TG * 256 * 2 + (size_t)u.pm * BM * 128 * 2; u.B = wb + W_UP + 768 * 256 * 2 + (size_t)(u.pn - 3) * BM * 128 * 2; }
        return true;
    }
};
struct SchedMix {
    const char* ws; const char* wb; int G, c, rep;
    DI bool next(int i, Unit& u) const {
        int tile = (i >> 3) * G + c; if (tile >= 256 * rep) return false; tile &= 255;
        const int sub = i & 7, j = sub >> 1; u.pm = (tile & 7) * 8 + (tile >> 5); u.pn = (tile >> 3) & 3; u.tag = sub;
        if ((sub & 1) == 0) { u.K = 1024; u.A = ws + WS_H + (size_t)u.pm * BM * 1024 * 2; u.B = wb + W_GT + (size_t)(j * 1024 + u.pn * BM) * 1024 * 2; }
        else { const int Kj = (j == 1) ? 256 : 512;
            const size_t ao = WS_OA + (size_t)j * (16 * MiB) - (j >= 2 ? 8 * MiB : 0);
            const size_t bo = W_PA + (size_t)j * MiB - (j >= 2 ? MiB / 2 : 0);
            u.K = Kj; u.A = ws + ao + (size_t)u.pm * BM * Kj * 2; u.B = wb + bo + (size_t)u.pn * BM * Kj * 2; }
        return true;
    }
};
}
using pg8::Unit;

template <int ACT>
DI void store_plain(const f32x4 (&acc)[2][2][4][2], bf16_t* dst, int ld, float scale, int row0, int wc, int fq) {
#pragma unroll
    for (int ai = 0; ai < 2; ++ai)
#pragma unroll
        for (int m = 0; m < 4; ++m) {
            bf16_t* rowp = dst + (size_t)(row0 + ai * 128 + m * 16) * ld + wc * 32 + 8 * fq;
#pragma unroll
            for (int bj = 0; bj < 2; ++bj) {
                f32x4 v0 = acc[ai][bj][m][0] * scale, v1 = acc[ai][bj][m][1] * scale;
                if (ACT == 1) { v0[0] = siluf(v0[0]); v0[1] = siluf(v0[1]); v0[2] = siluf(v0[2]); v0[3] = siluf(v0[3]); v1[0] = siluf(v1[0]); v1[1] = siluf(v1[1]); v1[2] = siluf(v1[2]); v1[3] = siluf(v1[3]); }
                u32x4 w; w.x = cvt_pk_bf16(v0[0], v0[1]); w.y = cvt_pk_bf16(v0[2], v0[3]); w.z = cvt_pk_bf16(v1[0], v1[1]); w.w = cvt_pk_bf16(v1[2], v1[3]);
                *(u32x4*)(rowp + bj * 128) = w;
            }
        }
}
DI void store_rope(const f32x4 (&acc)[2][2][4][2], bf16_t* dst, int ld, int hstride, float scale, const float* rc, const float* rs, int row0, int wc, int fq) {
    const int i0 = 16 * (wc & 1) + 4 * fq;
#pragma unroll
    for (int ai = 0; ai < 2; ++ai)
#pragma unroll
        for (int m = 0; m < 4; ++m) {
            const int row = row0 + ai * 128 + m * 16, pos = row & (SEQ - 1);
            const f32x4 c = *(const f32x4*)(rc + pos * 32 + i0), s = *(const f32x4*)(rs + pos * 32 + i0);
#pragma unroll
            for (int bj = 0; bj < 2; ++bj) {
                const int head = 2 * bj + (wc >> 1);
                const f32x4 x1 = acc[ai][bj][m][0] * scale, x2 = acc[ai][bj][m][1] * scale;
                const f32x4 o1 = x1 * c - x2 * s, o2 = x2 * c + x1 * s;
                bf16_t* p = dst + (size_t)row * ld + head * hstride + i0;
                u32x2 w; w.x = cvt_pk_bf16(o1[0], o1[1]); w.y = cvt_pk_bf16(o1[2], o1[3]); *(u32x2*)p = w;
                w.x = cvt_pk_bf16(o2[0], o2[1]); w.y = cvt_pk_bf16(o2[2], o2[3]); *(u32x2*)(p + 32) = w;
            }
        }
}

struct EpiIn {
    unsigned char* ws;
    template <class St> DI void operator()(const f32x4 (&acc)[2][2][4][2], const Unit& u, int wr, int wc, int fr, int fq, St& est) const {
        bf16_t* const LAT = (bf16_t*)(ws + WS_LAT); bf16_t* const MK = (bf16_t*)(ws + WS_MK); bf16_t* const BQKV = (bf16_t*)(ws + WS_BQKV);
        bf16_t* const CQ = (bf16_t*)(ws + WS_CQ); bf16_t* const CK = (bf16_t*)(ws + WS_CK); bf16_t* const CV = (bf16_t*)(ws + WS_CV);
        bf16_t* const DQ = (bf16_t*)(ws + WS_DQ); bf16_t* const DK = (bf16_t*)(ws + WS_DK); bf16_t* const DV = (bf16_t*)(ws + WS_DV); bf16_t* const Z = (bf16_t*)(ws + WS_Z);
        float* const GFB = (float*)(ws + WS_GFB); float* const SSQ = (float*)(ws + WS_SSQ); const float* const rc = (const float*)(ws + WS_ROPEC); const float* const rs = (const float*)(ws + WS_ROPES);
        const int pn = u.pn, row0 = u.pm * 256 + wr * 64 + fr, lane = fq * 16 + fr;
        if (pn == 0) {
            store_plain<0>(acc, LAT, 256, 1.f, row0, wc, fq);
#pragma unroll
            for (int ai = 0; ai < 2; ++ai)
#pragma unroll
                for (int m = 0; m < 4; ++m) {
                    float s = 0.f;
#pragma unroll
                    for (int bj = 0; bj < 2; ++bj)
#pragma unroll
                        for (int n = 0; n < 2; ++n) { const f32x4 v = acc[ai][bj][m][n]; s += v[0] * v[0] + v[1] * v[1] + v[2] * v[2] + v[3] * v[3]; }
                    s += shx(s, 16, lane); s += shx(s, 32, lane);
                    if (fq == 0 && u.tag == 0) atomicAdd(SSQ + (size_t)(row0 + ai * 128 + m * 16) * 2, s);
                }
        } else if (pn == 1) {
#pragma unroll
            for (int ai = 0; ai < 2; ++ai)
#pragma unroll
                for (int m = 0; m < 4; ++m) {
                    const int row = row0 + ai * 128 + m * 16;
                    float s = 0.f;
#pragma unroll
                    for (int n = 0; n < 2; ++n) { const f32x4 v = acc[ai][0][m][n]; s += v[0] * v[0] + v[1] * v[1] + v[2] * v[2] + v[3] * v[3]; }
                    { const f32x4 v0 = acc[ai][0][m][0], v1 = acc[ai][0][m][1]; u32x4 w; w.x = cvt_pk_bf16(v0[0], v0[1]); w.y = cvt_pk_bf16(v0[2], v0[3]); w.z = cvt_pk_bf16(v1[0], v1[1]); w.w = cvt_pk_bf16(v1[2], v1[3]);
                      *(u32x4*)(LAT + (size_t)TG * 256 + (size_t)row * 128 + wc * 32 + 8 * fq) = w; }
                    s += shx(s, 16, lane); s += shx(s, 32, lane);
                    if (fq == 0 && u.tag == 0) atomicAdd(SSQ + (size_t)row * 2 + 1, s);
                    if (wc < 2) {
                        const int i0 = 16 * wc + 4 * fq, pos = row & (SEQ - 1);
                        const f32x4 c = *(const f32x4*)(rc + pos * 32 + i0), sn = *(const f32x4*)(rs + pos * 32 + i0);
                        const f32x4 x1 = acc[ai][1][m][0], x2 = acc[ai][1][m][1];
                        const f32x4 o1 = x1 * c - x2 * sn, o2 = x2 * c + x1 * sn;
                        u32x2 w1, w2; w1.x = cvt_pk_bf16(o1[0], o1[1]); w1.y = cvt_pk_bf16(o1[2], o1[3]); w2.x = cvt_pk_bf16(o2[0], o2[1]); w2.y = cvt_pk_bf16(o2[2], o2[3]);
#pragma unroll
                        for (int hh = 0; hh < 4; ++hh) { bf16_t* p = MK + (size_t)row * 768 + hh * 192 + 128 + i0; *(u32x2*)p = w1; *(u32x2*)(p + 32) = w2; }
                    } else if (wc == 2) {
#pragma unroll
                        for (int n = 0; n < 2; ++n) *(f32x4*)(GFB + (size_t)row * 32 + n * 16 + 4 * fq) = acc[ai][1][m][n];
                    }
                }
        } else if (pn <= 10) {
            const int s = pn - 2, which = s % 3; bf16_t* dst = BQKV + (size_t)s * TG * 256;
            if (which == 2) store_plain<0>(acc, dst, 256, 1.f, row0, wc, fq);
            else store_rope(acc, dst, 256, 64, which == 0 ? 0.125f : 1.f, rc, rs, row0, wc, fq);
        } else if (pn <= 16) {
            const int t = pn - 11, buf = t >> 1; bf16_t* dst = (buf == 0 ? CQ : (buf == 1 ? CK : CV)) + (t & 1) * 256;
            store_plain<0>(acc, dst, 512, buf == 0 ? 0.125f : 1.f, row0, wc, fq);
        } else if (pn == 17) store_plain<0>(acc, DQ, 256, 0.125f, row0, wc, fq);
        else if (pn == 18) store_plain<0>(acc, DK, 256, 1.f, row0, wc, fq);
        else if (pn <= 20) store_plain<0>(acc, DV + (pn - 19) * 256, 512, 1.f, row0, wc, fq);
        else store_plain<1>(acc, Z + (pn - 21) * 256, 1792, 1.f, row0, wc, fq);
    }
};

struct EpiUp {
    unsigned char* ws;
    template <class St> DI void operator()(const f32x4 (&acc)[2][2][4][2], const Unit& u, int wr, int wc, int fr, int fq, St& est) const {
        bf16_t* const MQ = (bf16_t*)(ws + WS_MQ); bf16_t* const MK = (bf16_t*)(ws + WS_MK); bf16_t* const MV = (bf16_t*)(ws + WS_MV);
        const float* const SSQ = (const float*)(ws + WS_SSQ); const float* const rc = (const float*)(ws + WS_ROPEC); const float* const rs = (const float*)(ws + WS_ROPES);
        const int pn = u.pn, row0 = u.pm * 256 + wr * 64 + fr;
#pragma unroll
        for (int ai = 0; ai < 2; ++ai)
#pragma unroll
            for (int m = 0; m < 4; ++m) {
                const int row = row0 + ai * 128 + m * 16;
                const float rsc = (pn < 3) ? rsqrtf(SSQ[(size_t)row * 2] * (1.f / 256.f) + EPS) * QSCALE : rsqrtf(SSQ[(size_t)row * 2 + 1] * (1.f / 128.f) + EPS);
                if (pn == 2) {
                    const int i0 = 16 * (wc & 1) + 4 * fq, pos = row & (SEQ - 1);
                    const f32x4 c = *(const f32x4*)(rc + pos * 32 + i0), sn = *(const f32x4*)(rs + pos * 32 + i0);
#pragma unroll
                    for (int bj = 0; bj < 2; ++bj) {
                        const int head = 2 * bj + (wc >> 1);
                        const f32x4 x1 = acc[ai][bj][m][0] * rsc, x2 = acc[ai][bj][m][1] * rsc;
                        const f32x4 o1 = x1 * c - x2 * sn, o2 = x2 * c + x1 * sn;
                        bf16_t* p = MQ + (size_t)row * 768 + head * 192 + 128 + i0;
                        u32x2 w; w.x = cvt_pk_bf16(o1[0], o1[1]); w.y = cvt_pk_bf16(o1[2], o1[3]); *(u32x2*)p = w;
                        w.x = cvt_pk_bf16(o2[0], o2[1]); w.y = cvt_pk_bf16(o2[2], o2[3]); *(u32x2*)(p + 32) = w;
                    }
                } else {
#pragma unroll
                    for (int bj = 0; bj < 2; ++bj) {
                        bf16_t* p;
                        if (pn < 2) p = MQ + (size_t)row * 768 + (2 * pn + bj) * 192;
                        else if (pn < 5) p = MK + (size_t)row * 768 + (2 * (pn - 3) + bj) * 192;
                        else p = MV + (size_t)row * 512 + (pn - 5) * 256 + bj * 128;
                        p += wc * 32 + 8 * fq;
                        { const f32x4 v0 = acc[ai][bj][m][0] * rsc, v1 = acc[ai][bj][m][1] * rsc; u32x4 w; w.x = cvt_pk_bf16(v0[0], v0[1]); w.y = cvt_pk_bf16(v0[2], v0[3]); w.z = cvt_pk_bf16(v1[0], v1[1]); w.w = cvt_pk_bf16(v1[2], v1[3]);
                          *(u32x4*)p = w; }
                    }
                }
            }
    }
};

struct MixState { u32x4 g[8]; };
struct EpiMix {
    unsigned char* ws; const float* bm;
    template <class St> DI void operator()(const f32x4 (&acc)[2][2][4][2], const Unit& u, int wr, int wc, int fr, int fq, St& est) const {
        const int j = u.tag >> 1; const unsigned toff = (unsigned)((wr * 4 + wc) * 64 + fq * 16 + fr);
        unsigned char* const gbase = ws + WS_SCRG + (size_t)blockIdx.x * (8 * 512 * 16);
        unsigned char* const abase = ws + WS_MIXACC + (size_t)blockIdx.x * (8 * 512 * 32);
        if ((u.tag & 1) == 0) {
            const float* bp = bm + j * 1024 + u.pn * 256 + wc * 32 + 8 * fq;
            f32x4 b[2][2];
#pragma unroll
            for (int bj = 0; bj < 2; ++bj)
#pragma unroll
                for (int n = 0; n < 2; ++n) b[bj][n] = *(const f32x4*)(bp + bj * 128 + n * 4);
#pragma unroll
            for (int ai = 0; ai < 2; ++ai)
#pragma unroll
                for (int m = 0; m < 4; ++m) {
                    u32x4 w;
#pragma unroll
                    for (int bj = 0; bj < 2; ++bj)
#pragma unroll
                        for (int n = 0; n < 2; ++n) {
                            const f32x4 v = acc[ai][bj][m][n] + b[bj][n];
                            unsigned q = 0u;
                            q = __builtin_amdgcn_cvt_pk_u8_f32(__builtin_rintf(sigmf(v[0]) * 255.f), 0, q); q = __builtin_amdgcn_cvt_pk_u8_f32(__builtin_rintf(sigmf(v[1]) * 255.f), 1, q);
                            q = __builtin_amdgcn_cvt_pk_u8_f32(__builtin_rintf(sigmf(v[2]) * 255.f), 2, q); q = __builtin_amdgcn_cvt_pk_u8_f32(__builtin_rintf(sigmf(v[3]) * 255.f), 3, q);
                            if (bj == 0) { if (n == 0) w.x = q; else w.y = q; } else { if (n == 0) w.z = q; else w.w = q; }
                        }
                    est.g[ai * 4 + m] = w;
                }
        } else {
            const int row0 = u.pm * 256 + wr * 64 + fr;
            bf16_t* const MIXED = (bf16_t*)(ws + WS_MIXED);
#pragma unroll
            for (int ai = 0; ai < 2; ++ai)
#pragma unroll
                for (int m = 0; m < 4; ++m) {
                    asm volatile("" ::: "memory");
                    const u32x4 gq = est.g[ai * 4 + m];
                    u32x4* ap = (u32x4*)(abase + (ai * 4 + m) * (512 * 32) + toff * 32u);
                    u32x4 m0 = (u32x4){0u, 0u, 0u, 0u}, m1 = m0;
                    if (j > 0) { m0 = ap[0]; m1 = ap[1]; }
                    u32x4 r0, r1;
#pragma unroll
                    for (int bj = 0; bj < 2; ++bj) {
                        const u32x4 mm = bj ? m1 : m0;
#pragma unroll
                        for (int n = 0; n < 2; ++n) {
                            const unsigned gw_ = (bj == 0) ? (n ? gq.y : gq.x) : (n ? gq.w : gq.z), ax = n ? mm.z : mm.x, ay = n ? mm.w : mm.y; const f32x4 a = acc[ai][bj][m][n] * (1.f / 255.f);
                            f32x4 v; v[0] = (float)(gw_ & 0xffu) * a[0] + bflo(ax); v[1] = (float)((gw_ >> 8) & 0xffu) * a[1] + bfhi(ax); v[2] = (float)((gw_ >> 16) & 0xffu) * a[2] + bflo(ay); v[3] = (float)(gw_ >> 24) * a[3] + bfhi(ay);
                            const unsigned wx = cvt_pk_bf16(v[0], v[1]), wy = cvt_pk_bf16(v[2], v[3]);
                            if (j < 3) { if (bj == 0) { if (n == 0) { r0.x = wx; r0.y = wy; } else { r0.z = wx; r0.w = wy; } } else { if (n == 0) { r1.x = wx; r1.y = wy; } else { r1.z = wx; r1.w = wy; } } }
                            else { u32x2 w; w.x = wx; w.y = wy;
                                *(u32x2*)(MIXED + (size_t)(row0 + ai * 128 + m * 16) * 1024 + u.pn * 256 + bj * 128 + wc * 32 + 8 * fq + n * 4) = w; }
                        }
                    }
                    if (j < 3) { ap[0] = r0; ap[1] = r1; }
                }
        }
    }
};

struct EpiOut {
    const float* base; float* out;
    template <class St> DI void operator()(const f32x4 (&acc)[2][2][4][2], const Unit& u, int wr, int wc, int fr, int fq, St& est) const {
        const int row0 = u.pm * 256 + wr * 64 + fr; const float sc = u.tag ? 0.f : 1.f;
#pragma unroll
        for (int ai = 0; ai < 2; ++ai)
#pragma unroll
            for (int m = 0; m < 4; ++m) {
                const size_t off = (size_t)(row0 + ai * 128 + m * 16) * 1024 + u.pn * 256 + wc * 32 + 8 * fq;
#pragma unroll
                for (int bj = 0; bj < 2; ++bj)
#pragma unroll
                    for (int n = 0; n < 2; ++n) { const f32x4 b = *(const f32x4*)(base + off + bj * 128 + n * 4); *(f32x4*)(out + off + bj * 128 + n * 4) = b + acc[ai][bj][m][n] * sc; }
                if (m & 1) asm volatile("" ::: "memory");
            }
    }
};

template <class F>
DI void prep_mat(F f, bf16_t* dst, int N, int K, LAS float* scr, int gw, int NGW, int lane) {
    const int nblk = N / 32, items = (K / 64) * nblk;
    #pragma clang loop vectorize(disable) interleave(disable) unroll(disable)
    for (int it = gw; it < items; it += NGW) {
        const int kb = it / nblk, nb = it % nblk, k0 = kb * 64, n0 = nb * 32;
#pragma unroll
        for (int i = 0; i < 8; ++i) { const int kk = 8 * i + (lane >> 3), n4 = (lane & 7) * 4; const f32x4 v = f(k0 + kk, n0 + n4);
            LAS float* d = scr + kk * 33 + n4; d[0] = v[0]; d[1] = v[1]; d[2] = v[2]; d[3] = v[3]; }
        asm volatile("s_waitcnt lgkmcnt(0)" ::: "memory");
        const int c = lane & 7;
#pragma unroll
        for (int j = 0; j < 4; ++j) {
            const int n = (lane >> 3) + 8 * j; const LAS float* s = scr + (8 * c) * 33 + n;
            u32x4 o; o.x = cvt_pk_bf16(s[0], s[33]); o.y = cvt_pk_bf16(s[2 * 33], s[3 * 33]); o.z = cvt_pk_bf16(s[4 * 33], s[5 * 33]); o.w = cvt_pk_bf16(s[6 * 33], s[7 * 33]);
            *(u32x4*)(dst + (size_t)(n0 + n) * K + k0 + 8 * c) = o;
        }
        asm volatile("s_waitcnt lgkmcnt(0)" ::: "memory");
    }
}
DI int map_in(int n) {
    const int t = n >> 8, c = n & 255;
    if (t == 0) return pcol(c);
    if (t == 1) { if (c < 128) return 256 + pcol(c); if (c < 192) return 384 + rope_perm(c - 128); if (c < 208) return 5312 + (c - 192); if (c < 224) return 5328 + (c - 208); return -1; }
    if (t <= 10) { const int s = t - 2, which = s % 3; const int cc = (which == 2) ? pcol(c) : ((c & ~63) | rope_perm(c & 63)); return 448 + s * 256 + cc; }
    if (t <= 16) return 2752 + (t - 11) * 256 + pcol(c);
    if (t <= 20) return 4288 + (t - 17) * 256 + pcol(c);
    return 5344 + (t - 21) * 256 + pcol(c);
}

struct Params { const float* in[21]; float* out; unsigned char* ws; int ph_lo, ph_hi; };
typedef const __attribute__((address_space(4))) Params* KP;

DI void phase_prep(KP p, LAS unsigned char* lds, int tid, int wave, int lane, int G) {
    LAS float* scr = (LAS float*)(lds + wave * 16384);
    const int gw = blockIdx.x * 8 + wave, NGW = G * 8;
    for (int l = 0; l < 2; ++l) {
        unsigned char* wb = p->ws + WS_W + l * W_LSTRIDE;
        { const float* w = p->in[2] + (size_t)l * DM * DIN;
          prep_mat([=](int k, int n) -> f32x4 { const int c = map_in(n); return c < 0 ? (f32x4){0.f, 0.f, 0.f, 0.f} : *(const f32x4*)(w + (size_t)k * DIN + c); }, (bf16_t*)(wb + W_1T), 7168, 1024, scr, gw, NGW, lane); }
        { const float* w = p->in[17] + (size_t)l * DM * 4096;
          prep_mat([=](int k, int n) -> f32x4 { return *(const f32x4*)(w + (size_t)k * 4096 + pcol(n)); }, (bf16_t*)(wb + W_GT), 4096, 1024, scr, gw, NGW, lane); }
        { const float* wq = p->in[4] + (size_t)l * 256 * 768; const float* gq = p->in[3] + l * 256;
          prep_mat([=](int k, int n) -> f32x4 { const int t = n >> 8, c = n & 255;
              const int nl = pcol(n); const int col = (t < 2) ? ((nl >> 7) * 192 + (nl & 127)) : ((c >> 6) * 192 + 128 + rope_perm(c & 63)); return *(const f32x4*)(wq + (size_t)k * 768 + col) * gq[k]; }, (bf16_t*)(wb + W_UP), 768, 256, scr, gw, NGW, lane); }
        { const float* wkv = p->in[6] + (size_t)l * 128 * 1024; const float* gkv = p->in[5] + l * 128;
          prep_mat([=](int k, int n) -> f32x4 { const int nn = pcol(n) & 511; const int col = (nn >> 7) * 256 + (n >= 512 ? 128 : 0) + (nn & 127); return *(const f32x4*)(wkv + (size_t)k * 1024 + col) * gkv[k]; },
                   (bf16_t*)(wb + W_UP + 768 * 256 * 2), 1024, 128, scr, gw, NGW, lane); }
        { const float* w = p->in[13] + (size_t)l * 512 * 1024; prep_mat([=](int k, int n) -> f32x4 { return *(const f32x4*)(w + (size_t)k * 1024 + pcol(n)); }, (bf16_t*)(wb + W_PA), 1024, 512, scr, gw, NGW, lane); }
        { const float* w = p->in[14] + (size_t)l * 256 * 1024; prep_mat([=](int k, int n) -> f32x4 { return *(const f32x4*)(w + (size_t)k * 1024 + pcol(n)); }, (bf16_t*)(wb + W_PB), 1024, 256, scr, gw, NGW, lane); }
        { const float* w = p->in[15] + (size_t)l * 512 * 1024; prep_mat([=](int k, int n) -> f32x4 { return *(const f32x4*)(w + (size_t)k * 1024 + pcol(n)); }, (bf16_t*)(wb + W_PC), 1024, 512, scr, gw, NGW, lane); }
        { const float* w = p->in[16] + (size_t)l * 512 * 1024; prep_mat([=](int k, int n) -> f32x4 { return *(const f32x4*)(w + (size_t)k * 1024 + pcol(n)); }, (bf16_t*)(wb + W_PD), 1024, 512, scr, gw, NGW, lane); }
        { const float* w = p->in[19] + (size_t)l * 1024 * 1024; prep_mat([=](int k, int n) -> f32x4 { return *(const f32x4*)(w + (size_t)k * 1024 + pcol(n)); }, (bf16_t*)(wb + W_OUT), 1024, 1024, scr, gw, NGW, lane); }
    }
    float* rc = (float*)(p->ws + WS_ROPEC); float* rs = (float*)(p->ws + WS_ROPES);
    #pragma clang loop vectorize(disable) interleave(disable) unroll(disable)
    for (int e = blockIdx.x * 512 + tid; e < SEQ * 32; e += G * 512) {
        const int pos = e >> 5, i = e & 31;
        const float inv = exp2f(-(float)i * (13.287712379549449f / 32.f));
        const float ang = (float)pos * inv;
        const float nrev = rintf(ang * 0.15915494309189535f);
        float r = fmaf(-nrev, 6.28125f, ang); r = fmaf(-nrev, 1.9353071795864769e-3f, r);
        rc[e] = __cosf(r); rs[e] = __sinf(r);
    }
}

DI void phase_rms(const float* xsrc, const float* gain, bf16_t* H, float* SSQ, int tid, int wave, int lane, int G) {
    const int gw = blockIdx.x * 8 + wave, NGW = G * 8;
    #pragma clang loop vectorize(disable) interleave(disable) unroll(disable)
    for (int m = gw; m < TG; m += NGW) {
        const f32x4* xr = (const f32x4*)(xsrc + (size_t)m * DM) + lane;
        f32x4 v[4]; float s = 0.f;
#pragma unroll
        for (int j = 0; j < 4; ++j) { v[j] = xr[64 * j]; s += v[j][0] * v[j][0] + v[j][1] * v[j][1] + v[j][2] * v[j][2] + v[j][3] * v[j][3]; }
        const float r = rsqrtf(wave_sum(s, lane) * (1.f / DM) + EPS);
        u32x2* o = (u32x2*)(H + (size_t)m * DM) + lane;
#pragma unroll
        for (int j = 0; j < 4; ++j) { const f32x4 g = ((const f32x4*)gain)[lane + 64 * j]; u32x2 w; w.x = cvt_pk_bf16(v[j][0] * r * g[0], v[j][1] * r * g[1]); w.y = cvt_pk_bf16(v[j][2] * r * g[2], v[j][3] * r * g[3]); o[64 * j] = w; }
    }
    #pragma clang loop vectorize(disable) interleave(disable) unroll(disable)
    for (int e = blockIdx.x * 512 + tid; e < TG * 2; e += G * 512) SSQ[e] = 0.f;
}
DI void phase_final(float* x, const float* gain, int wave, int lane, int G) {
    const int gw = blockIdx.x * 8 + wave, NGW = G * 8;
    #pragma clang loop vectorize(disable) interleave(disable) unroll(disable)
    for (int m = gw; m < TG * NGRP; m += NGW) {
        f32x4* xr = (f32x4*)(x + (size_t)m * DM) + lane;
        f32x4 v[4]; float s = 0.f;
#pragma unroll
        for (int j = 0; j < 4; ++j) { v[j] = xr[64 * j]; s += v[j][0] * v[j][0] + v[j][1] * v[j][1] + v[j][2] * v[j][2] + v[j][3] * v[j][3]; }
        const float r = rsqrtf(wave_sum(s, lane) * (1.f / DM) + EPS);
#pragma unroll
        for (int j = 0; j < 4; ++j) { const f32x4 g = ((const f32x4*)gain)[lane + 64 * j]; xr[64 * j] = v[j] * r * g; }
    }
}

constexpr int GL_LAF = 0, GL_LAB = 16384, GL_KTF = 32768, GL_KTB = 32768 + 9216, GL_V1 = 32768 + 18432;
constexpr int G3_V = 32768, G3_SF = 32768 + 17408, G3_SB = 32768 + 2 * 17408;
constexpr int GLW_G = 104448, GLW_W = 104448 + 8192;
DI void gla_la_store(LAS unsigned char* lds, const float* GFB, const float* wgf, const float* bgf, const float* wgb, const float* bgb, int tok0, int h, int tid) {
    {
        const int row = tid >> 3, c4 = (tid & 7) * 4;
        const f32x4 gv_ = *(const f32x4*)(GFB + (size_t)(tok0 + row) * 32 + c4);
        const int idx = tid * 4, dir_ = idx >> 10, r_ = (idx >> 6) & 15, dk_ = idx & 63;
        const f32x4 wv_ = *(const f32x4*)((dir_ ? wgb : wgf) + r_ * 256 + h * 64 + dk_);
        *(LAS f32x4*)(lds + GLW_G + (row * 32 + c4) * 4) = gv_;
        *(LAS f32x4*)(lds + GLW_W + idx * 4) = wv_;
    }
    __syncthreads();
    {
        const int tok = tid >> 3, dk0 = (tid & 7) * 8;
        const LAS float* gp = (const LAS float*)(lds + GLW_G) + tok * 32;
#pragma unroll
        for (int dir = 0; dir < 2; ++dir) {
            const LAS float* w = (const LAS float*)(lds + GLW_W) + dir * 1024 + dk0; const float* b = (dir ? bgb : bgf) + h * 64 + dk0;
            f32x4 a0 = *(const f32x4*)b, a1 = *(const f32x4*)(b + 4);
#pragma unroll
            for (int r4 = 0; r4 < 4; ++r4) { const f32x4 gv = *(const LAS f32x4*)(gp + dir * 16 + r4 * 4);
#pragma unroll
                for (int e = 0; e < 4; ++e) { const int r = r4 * 4 + e; a0 += gv[e] * *(const LAS f32x4*)(w + r * 64); a1 += gv[e] * *(const LAS f32x4*)(w + r * 64 + 4); } }
            LAS float* o = (LAS float*)(lds + (dir ? GL_LAB : GL_LAF)) + tok * 64 + dk0;
            f32x4 r0, r1;
#pragma unroll
            for (int e = 0; e < 4; ++e) { const float x0 = a0[e], x1 = a1[e];
                r0[e] = (fminf(x0, 0.f) - __logf(1.0f + __expf(-fabsf(x0)))) * (1.f / 16.f); r1[e] = (fminf(x1, 0.f) - __logf(1.0f + __expf(-fabsf(x1)))) * (1.f / 16.f); }
            *(LAS f32x4*)o = r0; *(LAS f32x4*)(o + 4) = r1;
        }
    }
}
DI void gla_cumsum(LAS unsigned char* lds, int tid) {
    __syncthreads();
    const int col = tid & 127, seg = tid >> 7, dir = col >> 6, dk = col & 63;
    LAS float* a = (LAS float*)(lds + (dir ? GL_LAB : GL_LAF)) + dk + seg * 16 * 64;
    LAS float* tot = (LAS float*)(lds + GLW_G);
    float v[16];
#pragma unroll
    for (int t = 0; t < 16; ++t) v[t] = a[t * 64];
    if (dir == 0) {
#pragma unroll
        for (int t = 1; t < 16; ++t) v[t] += v[t - 1];
        tot[seg * 128 + col] = v[15];
    } else {
#pragma unroll
        for (int t = 14; t >= 0; --t) v[t] += v[t + 1];
        tot[seg * 128 + col] = v[0];
    }
    __syncthreads();
    float off = 0.f;
#pragma unroll
    for (int s2 = 0; s2 < 4; ++s2) { const float tt = tot[s2 * 128 + col]; off += ((dir == 0) ? (s2 < seg) : (s2 > seg)) ? tt : 0.f; }
#pragma unroll
    for (int t = 0; t < 16; ++t) a[t * 64] = v[t] + off;
    __syncthreads();
}

DI void gla_g1_item(LAS unsigned char* lds, KP p, int l, int item, int tid, int wave, int lane) {
    const int n = item & 63, h = (item >> 6) & 3, bl = item >> 8, tok0 = bl * SEQ + n * 64;
    const float* GFB = (const float*)(p->ws + WS_GFB);
    const bf16_t* DK = (const bf16_t*)(p->ws + WS_DK); const bf16_t* DV = (const bf16_t*)(p->ws + WS_DV);
    {
        const int tok = tid >> 3, dk0 = (tid & 7) * 8;
        const u32x4 kr = *(const u32x4*)(DK + (size_t)(tok0 + tok) * 256 + h * 64 + dk0);
        u32x4 vst[2];
#pragma unroll
        for (int i = 0; i < 2; ++i) { const int c = tid + 512 * i, row = c >> 4, ch = c & 15; vst[i] = *(const u32x4*)(DV + (size_t)(tok0 + row) * 512 + h * 128 + ch * 8); }
        gla_la_store(lds, GFB, p->in[8] + l * 4096, p->in[9] + l * 256, p->in[10] + l * 4096, p->in[11] + l * 256, tok0, h, tid);
#pragma unroll
        for (int i = 0; i < 2; ++i) { const int c = tid + 512 * i, row = c >> 4, ch = c & 15; *(LAS u32x4*)(lds + GL_V1 + row * 272 + ch * 16) = vst[i]; }
        gla_cumsum(lds, tid);
        const LAS float* lf = (const LAS float*)(lds + GL_LAF); const LAS float* lb = (const LAS float*)(lds + GL_LAB);
        float kf[8], kb[8];
        const f32x4 fl0 = *(const LAS f32x4*)(lf + 63 * 64 + dk0), fl1 = *(const LAS f32x4*)(lf + 63 * 64 + dk0 + 4), ft0 = *(const LAS f32x4*)(lf + tok * 64 + dk0), ft1 = *(const LAS f32x4*)(lf + tok * 64 + dk0 + 4);
        const f32x4 bl0 = *(const LAS f32x4*)(lb + dk0), bl1 = *(const LAS f32x4*)(lb + dk0 + 4), bt0 = *(const LAS f32x4*)(lb + tok * 64 + dk0), bt1 = *(const LAS f32x4*)(lb + tok * 64 + dk0 + 4);
        { unsigned char* lac = p->ws + WS_LAC + (size_t)item * 16384 + (size_t)(tok * 64 + dk0) * 2;
          const f32x8 vf = {ft0[0], ft0[1], ft0[2], ft0[3], ft1[0], ft1[1], ft1[2], ft1[3]}, vb = {bt0[0], bt0[1], bt0[2], bt0[3], bt1[0], bt1[1], bt1[2], bt1[3]};
          *(h16x8*)lac = __builtin_convertvector(vf, h16x8); *(h16x8*)(lac + 8192) = __builtin_convertvector(vb, h16x8); }
#pragma unroll
        for (int e = 0; e < 8; ++e) { const unsigned w = (e < 2) ? kr.x : (e < 4) ? kr.y : (e < 6) ? kr.z : kr.w; const float kv = (e & 1) ? bfhi(w) : bflo(w);
            const float fl = (e < 4) ? fl0[e & 3] : fl1[e & 3], ft = (e < 4) ? ft0[e & 3] : ft1[e & 3], bl_ = (e < 4) ? bl0[e & 3] : bl1[e & 3], bt = (e < 4) ? bt0[e & 3] : bt1[e & 3];
            kf[e] = kv * __expf(fl - ft); kb[e] = kv * __expf(bl_ - bt); }
        u32x4 o; o.x = cvt_pk_bf16(kf[0], kf[1]); o.y = cvt_pk_bf16(kf[2], kf[3]); o.z = cvt_pk_bf16(kf[4], kf[5]); o.w = cvt_pk_bf16(kf[6], kf[7]);
        *(LAS u32x4*)(lds + GL_KTF + tok * 144 + dk0 * 2) = o;
        o.x = cvt_pk_bf16(kb[0], kb[1]); o.y = cvt_pk_bf16(kb[2], kb[3]); o.z = cvt_pk_bf16(kb[4], kb[5]); o.w = cvt_pk_bf16(kb[6], kb[7]);
        *(LAS u32x4*)(lds + GL_KTB + tok * 144 + dk0 * 2) = o;
        if (tid < 128) { const int dir = tid >> 6, dk = tid & 63; float* DEC = (float*)(p->ws + WS_DEC);
            DEC[(size_t)(((dir * 16 + bl * 4 + h) * 64) + n) * 64 + dk] = __expf(dir ? lb[dk] : lf[63 * 64 + dk]); }
    }
    __syncthreads();
    {
        const int dir = wave >> 2, mt = wave & 3, i16 = lane & 15, g4 = lane >> 4, qq = i16 >> 2, pp = i16 & 3;
        LAS unsigned char* kt = lds + (dir ? GL_KTB : GL_KTF);
        bf16x8 af[2];
#pragma unroll
        for (int ks = 0; ks < 2; ++ks) { const int r0 = ks * 32 + 8 * g4 + qq;
            af[ks] = cat8(trread(kt + r0 * 144 + (mt * 16 + 4 * pp) * 2), trread(kt + (r0 + 4) * 144 + (mt * 16 + 4 * pp) * 2)); }
        bf16_t* KV = (bf16_t*)(p->ws + WS_KV) + (size_t)(((dir * 16 + bl * 4 + h) * 64) + n) * 8192;
#pragma unroll
        for (int nt = 0; nt < 8; ++nt) {
            f32x4 c = {0.f, 0.f, 0.f, 0.f};
#pragma unroll
            for (int ks = 0; ks < 2; ++ks) { const int r0 = ks * 32 + 8 * g4 + qq;
                const bf16x8 bfr = cat8(trread(lds + GL_V1 + r0 * 272 + (nt * 16 + 4 * pp) * 2), trread(lds + GL_V1 + (r0 + 4) * 272 + (nt * 16 + 4 * pp) * 2));
                c = mfma16(af[ks], bfr, c); }
#pragma unroll
            for (int r = 0; r < 4; ++r) KV[(size_t)(mt * 16 + 4 * g4 + r) * 128 + nt * 16 + i16] = (bf16_t)(cvt_pk_bf16(c[r], 0.f) & 0xffffu);
        }
    }
    __syncthreads();
}

DI void gla_scan(KP p, int G, int tid) {
    unsigned* KV = (unsigned*)(p->ws + WS_KV); const float* DEC = (const float*)(p->ws + WS_DEC);
    #pragma clang loop vectorize(disable) interleave(disable) unroll(disable)
    for (int e = blockIdx.x * 512 + tid; e < 2 * 16 * 4096; e += G * 512) {
        const int dir = e >> 16, blh = (e >> 12) & 15, pidx = e & 4095, dk = pidx >> 6;
        unsigned* kv = KV + (size_t)((dir * 16 + blh) * 64) * 4096 + pidx; const float* dc = DEC + (size_t)((dir * 16 + blh) * 64) * 64 + dk;
        float s0 = 0.f, s1 = 0.f;
        for (int b = 0; b < 4; ++b) {
            unsigned w[16]; float d[16];
#pragma unroll
            for (int i = 0; i < 16; ++i) { const int st = b * 16 + i, n = dir ? 63 - st : st; w[i] = kv[(size_t)n * 4096]; d[i] = dc[n * 64]; }
#pragma unroll
            for (int i = 0; i < 16; ++i) { const int st = b * 16 + i, n = dir ? 63 - st : st; kv[(size_t)n * 4096] = cvt_pk_bf16(s0, s1); s0 = d[i] * s0 + bflo(w[i]); s1 = d[i] * s1 + bfhi(w[i]); }
        }
    }
}

DI void gla_g3_item(LAS unsigned char* lds, KP p, int l, int item, int tid, int wave, int lane) {
    const int n = item & 63, h = (item >> 6) & 3, bl = item >> 8, tok0 = bl * SEQ + n * 64;
    const float* GFB = (const float*)(p->ws + WS_GFB);
    const bf16_t* DQ = (const bf16_t*)(p->ws + WS_DQ); const bf16_t* DK = (const bf16_t*)(p->ws + WS_DK); const bf16_t* DV = (const bf16_t*)(p->ws + WS_DV);
    const int dir = wave >> 2, it = wave & 3, i16 = lane & 15, g4 = lane >> 4, qq = i16 >> 2, pp = i16 & 3;
    u32x4 qraw[2], kraw[4][2];
#pragma unroll
    for (int ks = 0; ks < 2; ++ks) qraw[ks] = *(const u32x4*)(DQ + (size_t)(tok0 + it * 16 + i16) * 256 + h * 64 + ks * 32 + 8 * g4);
#pragma unroll
    for (int jt = 0; jt < 4; ++jt)
#pragma unroll
        for (int ks = 0; ks < 2; ++ks) kraw[jt][ks] = *(const u32x4*)(DK + (size_t)(tok0 + jt * 16 + i16) * 256 + h * 64 + ks * 32 + 8 * g4);
    {
        u32x4 stg[6];
#pragma unroll
        for (int i = 0; i < 2; ++i) { const int c = tid + 512 * i, row = c >> 4, ch = c & 15; stg[i] = *(const u32x4*)(DV + (size_t)(tok0 + row) * 512 + h * 128 + ch * 8); }
#pragma unroll
        for (int d2 = 0; d2 < 2; ++d2) {
            const bf16_t* KV = (const bf16_t*)(p->ws + WS_KV) + (size_t)(((d2 * 16 + bl * 4 + h) * 64) + n) * 8192;
#pragma unroll
            for (int i = 0; i < 2; ++i) { const int c = tid + 512 * i, row = c >> 4, ch = c & 15; stg[2 + d2 * 2 + i] = *(const u32x4*)(KV + (size_t)row * 128 + ch * 8); }
        }
        { const int tok_ = tid >> 3, dk0_ = (tid & 7) * 8;
          const unsigned char* lac = p->ws + WS_LAC + (size_t)item * 16384 + (size_t)(tok_ * 64 + dk0_) * 2;
          const f32x8 vf = __builtin_convertvector(*(const h16x8*)lac, f32x8), vb = __builtin_convertvector(*(const h16x8*)(lac + 8192), f32x8);
          LAS float* of = (LAS float*)(lds + GL_LAF) + tok_ * 64 + dk0_; LAS float* ob = (LAS float*)(lds + GL_LAB) + tok_ * 64 + dk0_;
          *(LAS f32x4*)of = (f32x4){vf[0], vf[1], vf[2], vf[3]}; *(LAS f32x4*)(of + 4) = (f32x4){vf[4], vf[5], vf[6], vf[7]};
          *(LAS f32x4*)ob = (f32x4){vb[0], vb[1], vb[2], vb[3]}; *(LAS f32x4*)(ob + 4) = (f32x4){vb[4], vb[5], vb[6], vb[7]}; }
#pragma unroll
        for (int i = 0; i < 2; ++i) { const int c = tid + 512 * i, row = c >> 4, ch = c & 15;
            *(LAS u32x4*)(lds + G3_V + row * 272 + ch * 16) = stg[i]; *(LAS u32x4*)(lds + G3_SF + row * 272 + ch * 16) = stg[2 + i]; *(LAS u32x4*)(lds + G3_SB + row * 272 + ch * 16) = stg[4 + i]; }
    }
    __syncthreads();
    f32x4 o[8];
    {
        const LAS float* la = (const LAS float*)(lds + (dir ? GL_LAB : GL_LAF));
        const int midrow = dir ? 32 : 31, qi = it * 16 + i16;
        bf16x8 qt[2], qh[2]; f32x4 lmid[2][2];
#pragma unroll
        for (int ks = 0; ks < 2; ++ks) {
            const int d0 = ks * 32 + 8 * g4;
            const u32x4 qr = qraw[ks];
            float a[8], b[8];
            const f32x4 bq0 = *(const LAS f32x4*)(la + qi * 64 + d0), bq1 = *(const LAS f32x4*)(la + qi * 64 + d0 + 4);
            const f32x4 bm0 = *(const LAS f32x4*)(la + midrow * 64 + d0), bm1 = *(const LAS f32x4*)(la + midrow * 64 + d0 + 4);
            lmid[ks][0] = bm0; lmid[ks][1] = bm1;
#pragma unroll
            for (int e = 0; e < 8; ++e) { const unsigned w = (e < 2) ? qr.x : (e < 4) ? qr.y : (e < 6) ? qr.z : qr.w; const float qv = (e & 1) ? bfhi(w) : bflo(w);
                const float bi = (e < 4) ? bq0[e & 3] : bq1[e & 3], bm = (e < 4) ? bm0[e & 3] : bm1[e & 3]; a[e] = qv * __expf(bi - bm); b[e] = qv * __expf(bi); }
            qt[ks] = pack8((f32x4){a[0], a[1], a[2], a[3]}, (f32x4){a[4], a[5], a[6], a[7]});
            qh[ks] = pack8((f32x4){b[0], b[1], b[2], b[3]}, (f32x4){b[4], b[5], b[6], b[7]});
        }
        f32x4 att[4];
#pragma unroll
        for (int jt = 0; jt < 4; ++jt) {
            att[jt] = (f32x4){0.f, 0.f, 0.f, 0.f};
            const int kj = jt * 16 + i16;
#pragma unroll
            for (int ks = 0; ks < 2; ++ks) {
                const int d0 = ks * 32 + 8 * g4;
                const u32x4 kr = kraw[jt][ks];
                float a[8];
                const f32x4 bk0 = *(const LAS f32x4*)(la + kj * 64 + d0), bk1 = *(const LAS f32x4*)(la + kj * 64 + d0 + 4);
#pragma unroll
                for (int e = 0; e < 8; ++e) { const unsigned w = (e < 2) ? kr.x : (e < 4) ? kr.y : (e < 6) ? kr.z : kr.w; const float kv = (e & 1) ? bfhi(w) : bflo(w);
                    const float bk = (e < 4) ? bk0[e & 3] : bk1[e & 3], bm = (e < 4) ? lmid[ks][0][e & 3] : lmid[ks][1][e & 3]; a[e] = kv * __expf(bm - bk); }
                att[jt] = mfma16(pack8((f32x4){a[0], a[1], a[2], a[3]}, (f32x4){a[4], a[5], a[6], a[7]}), qt[ks], att[jt]);
            }
#pragma unroll
            for (int r = 0; r < 4; ++r) { const int j = jt * 16 + 4 * g4 + r; const bool keep = dir ? (j >= qi) : (j <= qi); att[jt][r] = keep ? att[jt][r] : 0.f; }
        }
        bf16x8 pf[2]; pf[0] = pack8(att[0], att[1]); pf[1] = pack8(att[2], att[3]);
        LAS unsigned char* sb = lds + (dir ? G3_SB : G3_SF);
#pragma unroll
        for (int dt = 0; dt < 8; ++dt) {
            f32x4 c = {0.f, 0.f, 0.f, 0.f};
            const int cb = (dt * 16 + 4 * pp) * 2;
#pragma unroll
            for (int s2 = 0; s2 < 2; ++s2) {
                const int ra = (2 * s2) * 16 + 4 * g4 + qq;
                c = mfma16(cat8(trread(lds + G3_V + ra * 272 + cb), trread(lds + G3_V + (ra + 16) * 272 + cb)), pf[s2], c);
            }
#pragma unroll
            for (int ks = 0; ks < 2; ++ks) {
                const int r0 = ks * 32 + 8 * g4 + qq;
                c = mfma16(cat8(trread(sb + r0 * 272 + cb), trread(sb + (r0 + 4) * 272 + cb)), qh[ks], c);
            }
            o[dt] = c;
        }
    }
    __syncthreads();
    LAS float* xo = (LAS float*)lds;
    if (dir == 1) {
#pragma unroll
        for (int dt = 0; dt < 8; ++dt)
#pragma unroll
            for (int r = 0; r < 4; ++r) xo[(it * 128 + dt * 16 + 4 * g4 + r) * 16 + i16] = o[dt][r];
    }
    __syncthreads();
    if (dir == 0) {
        float ss = 0.f;
#pragma unroll
        for (int dt = 0; dt < 8; ++dt)
#pragma unroll
            for (int r = 0; r < 4; ++r) { o[dt][r] += xo[(it * 128 + dt * 16 + 4 * g4 + r) * 16 + i16]; ss += o[dt][r] * o[dt][r]; }
        ss += shx(ss, 16, lane); ss += shx(ss, 32, lane);
        const float rn = rsqrtf(ss * (1.f / 128.f) + EPS);
        const int tok = tok0 + it * 16 + i16;
        const float* gn = p->in[12] + l * 512 + h * 128;
        const bf16_t* Z = (const bf16_t*)(p->ws + WS_Z) + (size_t)tok * 1792 + 1280 + h * 128;
        bf16_t* OD = (bf16_t*)(p->ws + WS_OD) + (size_t)tok * 512 + h * 128;
#pragma unroll
        for (int dt = 0; dt < 8; ++dt) {
            const int d = dt * 16 + 4 * g4;
            const f32x4 g = *(const f32x4*)(gn + d); const u32x2 z = *(const u32x2*)(Z + d);
            u32x2 w; w.x = cvt_pk_bf16(o[dt][0] * rn * g[0] * bflo(z.x), o[dt][1] * rn * g[1] * bfhi(z.x)); w.y = cvt_pk_bf16(o[dt][2] * rn * g[2] * bflo(z.y), o[dt][3] * rn * g[3] * bfhi(z.y));
            *(u32x2*)(OD + d) = w;
        }
    }
    __syncthreads();
}

constexpr int DL_K = 0, DL_V = 49152;
DI void dil_load(KP p, int item, int tid, u32x4 (&kr)[6], u32x4 (&vr)[6]) {
    const int hp = item & 1, sb = ((item >> 1) & 3) * 16 + ((item >> 3) & 15), bg_ = item >> 7, g = bg_ % 3, bl = bg_ / 3;
    const int lg = 2 * g, r = 1 << lg, L = SEQ >> lg, bpr = 64 >> lg, mres = sb / bpr, nb = sb % bpr;
    const bf16_t* Kb = (const bf16_t*)(p->ws + WS_BQKV) + (size_t)(g * 3 + 1) * TG * 256;
    const bf16_t* Vb = (const bf16_t*)(p->ws + WS_BQKV) + (size_t)(g * 3 + 2) * TG * 256;
#pragma unroll
    for (int i = 0; i < 6; ++i) {
        const int c = tid + 512 * i, kl = c >> 4, part = c & 15, ik = nb * 64 - 64 + kl;
        const bool ok = (ik >= 0) && (ik < L);
        const size_t tok = (size_t)bl * SEQ + (size_t)(ok ? ik : 0) * r + mres;
        u32x4 kv = *(const u32x4*)(Kb + tok * 256 + hp * 128 + part * 8), vv = *(const u32x4*)(Vb + tok * 256 + hp * 128 + part * 8);
        if (!ok) { kv = (u32x4){0u, 0u, 0u, 0u}; vv = kv; }
        kr[i] = kv; vr[i] = vv;
    }
}
DI void dil_store(LAS unsigned char* lds, int tid, const u32x4 (&kr)[6], const u32x4 (&vr)[6]) {
#pragma unroll
    for (int i = 0; i < 6; ++i) {
        const int c = tid + 512 * i, kl = c >> 4, part = c & 15, hh = part >> 3, piece = part & 7;
        const int off = (hh * 192 + kl) * 128 + ((piece ^ (kl & 7)) * 16);
        *(LAS u32x4*)(lds + DL_K + off) = kr[i]; *(LAS u32x4*)(lds + DL_V + off) = vr[i];
    }
}
DI void dil_compute(LAS unsigned char* lds, KP p, int item, int tid, int wave, int lane) {
    const int hp = item & 1, sb = ((item >> 1) & 3) * 16 + ((item >> 3) & 15), bg_ = item >> 7, g = bg_ % 3, bl = bg_ / 3;
    const int lg = 2 * g, r = 1 << lg, L = SEQ >> lg, bpr = 64 >> lg, mres = sb / bpr, nb = sb % bpr;
    const bf16_t* Qb = (const bf16_t*)(p->ws + WS_BQKV) + (size_t)(g * 3 + 0) * TG * 256;
    {
        const int hh = wave >> 2, qt = wave & 3, i16 = lane & 15, g4 = lane >> 4, qq = i16 >> 2, pp = i16 & 3;
        const int head = hp * 2 + hh, qi = qt * 16 + i16, iq = nb * 64 + qi;
        const size_t tokq = (size_t)bl * SEQ + (size_t)iq * r + mres;
        const bf16x8 qf0 = *(const bf16x8*)(Qb + tokq * 256 + head * 64 + 8 * g4), qf1 = *(const bf16x8*)(Qb + tokq * 256 + head * 64 + 32 + 8 * g4);
        f32x4 st[9];
        float mx = -1e30f;
#pragma unroll
        for (int t = 0; t < 9; ++t) {
            const int row = (qt + t) * 16 + i16;
            const LAS unsigned char* kp = lds + DL_K + (hh * 192 + row) * 128;
            f32x4 c = {0.f, 0.f, 0.f, 0.f};
            c = mfma16(*(const LAS bf16x8*)(kp + ((g4 ^ (row & 7)) * 16)), qf0, c);
            c = mfma16(*(const LAS bf16x8*)(kp + (((4 + g4) ^ (row & 7)) * 16)), qf1, c);
#pragma unroll
            for (int rr = 0; rr < 4; ++rr) {
                const int kl = (qt + t) * 16 + 4 * g4 + rr, ql = 64 + qi, ik = nb * 64 - 64 + kl, dlt = kl - ql;
                const bool ok = (dlt <= 64) && (dlt >= -64) && (ik >= 0) && (ik < L);
                c[rr] = ok ? c[rr] * LOG2E : -1e30f; mx = fmaxf(mx, c[rr]);
            }
            st[t] = c;
        }
        mx = fmaxf(mx, shx(mx, 16, lane)); mx = fmaxf(mx, shx(mx, 32, lane));
        float den = 0.f;
#pragma unroll
        for (int t = 0; t < 9; ++t)
#pragma unroll
            for (int rr = 0; rr < 4; ++rr) { const float e = ex2(st[t][rr] - mx); st[t][rr] = e; den += e; }
        den += shx(den, 16, lane); den += shx(den, 32, lane);
        bf16x8 pf[5];
#pragma unroll
        for (int s = 0; s < 4; ++s) pf[s] = pack8(st[2 * s], st[2 * s + 1]);
        pf[4] = pack8(st[8], (f32x4){0.f, 0.f, 0.f, 0.f});
        const float inv = 1.f / den;
        bf16_t* O = (bf16_t*)(p->ws + WS_OBG) + ((size_t)g * TG + tokq) * 256 + head * 64;
#pragma unroll
        for (int dt = 0; dt < 4; ++dt) {
            f32x4 c = {0.f, 0.f, 0.f, 0.f};
#pragma unroll
            for (int s = 0; s < 5; ++s) {
                const int ra = (qt + 2 * s) * 16 + 4 * g4 + qq, rb = (qt + (s < 4 ? 2 * s + 1 : 8)) * 16 + 4 * g4 + qq;
                const int cha = dt * 2 + (pp >> 1), bo = (pp & 1) * 8;
                const s16x4 lo = trread(lds + DL_V + (hh * 192 + ra) * 128 + ((cha ^ (ra & 7)) * 16) + bo);
                const s16x4 hi = trread(lds + DL_V + (hh * 192 + rb) * 128 + ((cha ^ (rb & 7)) * 16) + bo);
                c = mfma16(cat8(lo, hi), pf[s], c);
            }
            u32x2 w; w.x = cvt_pk_bf16(c[0] * inv, c[1] * inv); w.y = cvt_pk_bf16(c[2] * inv, c[3] * inv);
            *(u32x2*)(O + dt * 16 + 4 * g4) = w;
        }
        if (g4 == 0) ((float*)(p->ws + WS_LSE))[((size_t)g * TG + tokq) * 4 + head] = (mx + log2f(den)) * LN2;
    }
}
DI void dil_phase(LAS unsigned char* lds, KP p, int c, int G, int N, int tid, int wave, int lane) {
    if (c >= N) return;
    u32x4 kr[6], vr[6];
    dil_load(p, c % 1536, tid, kr, vr);
    for (int it = c; it < N; it += G) {
        dil_store(lds, tid, kr, vr);
        __syncthreads();
        if (it + G < N) dil_load(p, (it + G) % 1536, tid, kr, vr);
        dil_compute(lds, p, it % 1536, tid, wave, lane);
        __syncthreads();
    }
}

DI void dil_merge(KP p, int G, int tid) {
    const float* LSE = (const float*)(p->ws + WS_LSE); const bf16_t* OBG = (const bf16_t*)(p->ws + WS_OBG);
    const bf16_t* Z = (const bf16_t*)(p->ws + WS_Z); bf16_t* OB = (bf16_t*)(p->ws + WS_OB);
    #pragma clang loop vectorize(disable) interleave(disable) unroll(disable)
    for (int e = blockIdx.x * 512 + tid; e < TG * 32; e += G * 512) {
        const int tok = e >> 5, c8 = (e & 31) * 8, head = c8 >> 6;
        const float l0 = LSE[(size_t)tok * 4 + head], l1 = LSE[((size_t)TG + tok) * 4 + head], l2 = LSE[((size_t)2 * TG + tok) * 4 + head];
        const float mx = fmaxf(l0, fmaxf(l1, l2)); float w0 = __expf(l0 - mx), w1 = __expf(l1 - mx), w2 = __expf(l2 - mx);
        const float inv = 1.f / (w0 + w1 + w2); w0 *= inv; w1 *= inv; w2 *= inv;
        const u32x4 a = *(const u32x4*)(OBG + (size_t)tok * 256 + c8), b = *(const u32x4*)(OBG + ((size_t)TG + tok) * 256 + c8), c = *(const u32x4*)(OBG + ((size_t)2 * TG + tok) * 256 + c8);
        const u32x4 z = *(const u32x4*)(Z + (size_t)tok * 1792 + 512 + c8);
        u32x4 o;
        o.x = cvt_pk_bf16((w0 * bflo(a.x) + w1 * bflo(b.x) + w2 * bflo(c.x)) * bflo(z.x), (w0 * bfhi(a.x) + w1 * bfhi(b.x) + w2 * bfhi(c.x)) * bfhi(z.x));
        o.y = cvt_pk_bf16((w0 * bflo(a.y) + w1 * bflo(b.y) + w2 * bflo(c.y)) * bflo(z.y), (w0 * bfhi(a.y) + w1 * bfhi(b.y) + w2 * bfhi(c.y)) * bfhi(z.y));
        o.z = cvt_pk_bf16((w0 * bflo(a.z) + w1 * bflo(b.z) + w2 * bflo(c.z)) * bflo(z.z), (w0 * bfhi(a.z) + w1 * bfhi(b.z) + w2 * bfhi(c.z)) * bfhi(z.z));
        o.w = cvt_pk_bf16((w0 * bflo(a.w) + w1 * bflo(b.w) + w2 * bflo(c.w)) * bflo(z.w), (w0 * bfhi(a.w) + w1 * bfhi(b.w) + w2 * bfhi(c.w)) * bfhi(z.w));
        *(u32x4*)(OB + (size_t)tok * 256 + c8) = o;
    }
}

DI void nat_load(const bf16_t* src, size_t tokbase, int hp, int tid, u32x4 (&rg)[16]) {
#pragma unroll
    for (int i = 0; i < 16; ++i) { const int c = tid + 512 * i, key = c >> 4, part = c & 15; rg[i] = *(const u32x4*)(src + (tokbase + key) * 512 + hp * 128 + part * 8); }
}
DI void nat_store(LAS unsigned char* lds, int tid, const u32x4 (&rg)[16]) {
#pragma unroll
    for (int i = 0; i < 16; ++i) { const int c = tid + 512 * i, key = c >> 4, part = c & 15, hh = part >> 3, piece = part & 7;
        *(LAS u32x4*)(lds + (hh * 512 + key) * 128 + ((piece ^ (key & 7)) * 16)) = rg[i]; }
}
DI int nat_row(int item) { return ((item >> 2) & 1) * 32 + ((item >> 3) & 31); }
DI size_t nat_tokbase(int item) { const int r = nat_row(item), bl = item >> 8; return (size_t)bl * SEQ + clampi(r - 4, 0, 56) * 64; }
DI void nat_phase(LAS unsigned char* lds, KP p, int l, int c, int G, int N, int tid, int wave, int lane) {
    if (c >= N) return;
    const bf16_t* CQ = (const bf16_t*)(p->ws + WS_CQ); const bf16_t* CK = (const bf16_t*)(p->ws + WS_CK); const bf16_t* CV = (const bf16_t*)(p->ws + WS_CV);
    u32x4 rg[16];
    nat_load(CK, nat_tokbase(c & 1023), c & 3, tid, rg);
    for (int it = c; it < N; it += G) {
        const int item = it & 1023, hp = item & 3, r = nat_row(item), bl = item >> 8;
        const int rs0 = clampi(r - 4, 0, 56);
        const size_t tokbase = (size_t)bl * SEQ + rs0 * 64;
        nat_store(lds, tid, rg);
        { LAS float* bl_ = (LAS float*)(lds + 131072 + 256); const float* rp_ = p->in[7] + (size_t)l * 3720 + hp * 930;
          bl_[tid] = rp_[tid]; if (tid < 930 - 512) bl_[tid + 512] = rp_[tid + 512]; }
        __syncthreads();
        nat_load(CV, tokbase, hp, tid, rg);
        int ln = lane; asm volatile("" : "+v"(ln));
        const int hh = wave >> 2, jb = wave & 3, i16 = ln & 15, g4 = ln >> 4, qq = i16 >> 2, pp = i16 & 3;
        const int h = hp * 2 + hh, qcol = 16 * jb + i16, kcs = clampi(16 * jb - 8, 0, 32), wst = clampi(qcol - 8, 0, 48);
        const size_t tokq = (size_t)bl * SEQ + r * 64 + qcol;
        bf16x8 pf[8]; float den = 0.f;
        {
            const bf16x8 qf0 = *(const bf16x8*)(CQ + tokq * 512 + h * 64 + 8 * g4), qf1 = *(const bf16x8*)(CQ + tokq * 512 + h * 64 + 32 + 8 * g4);
            const LAS float* rpb = (const LAS float*)(lds + 131072 + 256) + hh * 465;
            f32x4 st[16]; float mx = -1e30f;
#pragma unroll
            for (int t = 0; t < 16; ++t) {
                const int kr = t >> 1, ct = t & 1, row = kr * 64 + kcs + ct * 16 + i16;
                const LAS unsigned char* kp = lds + (hh * 512 + row) * 128;
                f32x4 cc = {0.f, 0.f, 0.f, 0.f};
                cc = mfma16(*(const LAS bf16x8*)(kp + ((g4 ^ (row & 7)) * 16)), qf0, cc);
                cc = mfma16(*(const LAS bf16x8*)(kp + (((4 + g4) ^ (row & 7)) * 16)), qf1, cc);
                const int ro = rs0 + kr - r + 7;
#pragma unroll
                for (int rr = 0; rr < 4; ++rr) {
                    const int kcol = kcs + ct * 16 + 4 * g4 + rr;
                    const bool ok = (kcol >= wst) && (kcol < wst + 16);
                    const int co = clampi(kcol - qcol + 15, 0, 30);
                    const float b = rpb[ro * 31 + co];
                    cc[rr] = ok ? (cc[rr] + b) * LOG2E : -1e30f; mx = fmaxf(mx, cc[rr]);
                }
                st[t] = cc;
                if ((t & 3) == 3) asm volatile("" ::: "memory");
            }
            mx = fmaxf(mx, shx(mx, 16, lane)); mx = fmaxf(mx, shx(mx, 32, lane));
#pragma unroll
            for (int t = 0; t < 16; ++t)
#pragma unroll
                for (int rr = 0; rr < 4; ++rr) { const float e = ex2(st[t][rr] - mx); st[t][rr] = e; den += e; }
            den += shx(den, 16, lane); den += shx(den, 32, lane);
#pragma unroll
            for (int kr = 0; kr < 8; ++kr) pf[kr] = pack8(st[2 * kr], st[2 * kr + 1]);
        }
        __syncthreads();
        nat_store(lds, tid, rg);
        __syncthreads();
        if (it + G < N) { const int nx = (it + G) & 1023; nat_load(CK, nat_tokbase(nx), nx & 3, tid, rg); }
        {
            const float inv = 1.f / den;
            const bf16_t* Z = (const bf16_t*)(p->ws + WS_Z) + tokq * 1792 + 768 + h * 64;
            bf16_t* OC = (bf16_t*)(p->ws + WS_OC) + tokq * 512 + h * 64;
#pragma unroll
            for (int dt = 0; dt < 4; ++dt) {
                f32x4 cc = {0.f, 0.f, 0.f, 0.f};
                const int cha = dt * 2 + (pp >> 1), bo = (pp & 1) * 8;
#pragma unroll
                for (int kr = 0; kr < 8; ++kr) {
                    const int ra = kr * 64 + kcs + 4 * g4 + qq, rb = ra + 16;
                    const s16x4 lo = trread(lds + (hh * 512 + ra) * 128 + ((cha ^ (ra & 7)) * 16) + bo);
                    const s16x4 hi = trread(lds + (hh * 512 + rb) * 128 + ((cha ^ (rb & 7)) * 16) + bo);
                    cc = mfma16(cat8(lo, hi), pf[kr], cc);
                }
                const int d = dt * 16 + 4 * g4; const u32x2 z = *(const u32x2*)(Z + d);
                u32x2 w; w.x = cvt_pk_bf16(cc[0] * inv * bflo(z.x), cc[1] * inv * bfhi(z.x)); w.y = cvt_pk_bf16(cc[2] * inv * bflo(z.y), cc[3] * inv * bfhi(z.y));
                *(u32x2*)(OC + d) = w;
            }
        }
        __syncthreads();
    }
}

constexpr int FA_K0 = 0, FA_K1 = 24576, FA_V0 = 49152, FA_V1 = 49152 + 16384;
DI void mla_unit(LAS unsigned char* lds, KP p, int unit, int tid, int wave, int lane_in) {
    int lane = lane_in; asm volatile("" : "+v"(lane));
    const int grp = (unit & 7) * 2 + ((unit >> 3) >> 4), qb = (unit >> 3) & 15, h = grp & 3, bl = grp >> 2;
    const bf16_t* MQ = (const bf16_t*)(p->ws + WS_MQ); const bf16_t* MK = (const bf16_t*)(p->ws + WS_MK) + (size_t)bl * SEQ * 768 + h * 192;
    const bf16_t* MV = (const bf16_t*)(p->ws + WS_MV) + (size_t)bl * SEQ * 512 + h * 128;
    const int i16 = lane & 15, g4 = lane >> 4, qq = i16 >> 2, pp = i16 & 3;
    const size_t q0 = (size_t)bl * SEQ + qb * 256 + wave * 32;
    bf16x8 qf[2][6];
#pragma unroll
    for (int qt = 0; qt < 2; ++qt)
#pragma unroll
        for (int ks = 0; ks < 6; ++ks) qf[qt][ks] = *(const bf16x8*)(MQ + (q0 + qt * 16 + i16) * 768 + h * 192 + ks * 32 + 8 * g4);
    float mrun[2] = {-1e30f, -1e30f}, lrun[2] = {0.f, 0.f};
    f32x4 o[8][2];
#pragma unroll
    for (int dt = 0; dt < 8; ++dt) { o[dt][0] = (f32x4){0.f, 0.f, 0.f, 0.f}; o[dt][1] = (f32x4){0.f, 0.f, 0.f, 0.f}; }
    unsigned kgo[3], vgo[2];
#pragma unroll
    for (int i = 0; i < 3; ++i) { const int pidx = (wave * 3 + i) * 64 + lane, row = pidx / 24, cs = pidx % 24; kgo[i] = (unsigned)(row * 768 + ((cs ^ (row & 7)) * 8)) * 2u; }
#pragma unroll
    for (int i = 0; i < 2; ++i) { const int pidx = (wave * 2 + i) * 64 + lane, row = pidx >> 4, cs = pidx & 15; vgo[i] = (unsigned)(row * 512 + ((cs ^ (2 * (row & 7))) * 8)) * 2u; }
#define FA_STAGE(tile, kbo, vbo) do { const char* gk_ = (const char*)(MK + (size_t)(tile) * 64 * 768); const char* gv_ = (const char*)(MV + (size_t)(tile) * 64 * 512); \
        _Pragma("unroll") for (int i = 0; i < 3; ++i) __builtin_amdgcn_global_load_lds((const unsigned*)(gk_ + kgo[i]), (LAS unsigned*)(lds + (kbo) + (wave * 3 + i) * 1024), 16, 0, 0); \
        _Pragma("unroll") for (int i = 0; i < 2; ++i) __builtin_amdgcn_global_load_lds((const unsigned*)(gv_ + vgo[i]), (LAS unsigned*)(lds + (vbo) + (wave * 2 + i) * 1024), 16, 0, 0); } while (0)
    FA_STAGE(0, FA_K0, FA_V0);
    asm volatile("s_waitcnt vmcnt(0)" ::: "memory");
    __syncthreads();
    const int s7 = i16 & 7;
    for (int t = 0; t < 64; ++t) {
        const int cur = t & 1;
        const LAS unsigned char* kb = lds + (cur ? FA_K1 : FA_K0); LAS unsigned char* vb = lds + (cur ? FA_V1 : FA_V0);
        if (t + 1 < 64) FA_STAGE(t + 1, cur ? FA_K0 : FA_K1, cur ? FA_V0 : FA_V1);
        f32x4 st[4][2];
#pragma unroll
        for (int kt = 0; kt < 4; ++kt) { st[kt][0] = (f32x4){0.f, 0.f, 0.f, 0.f}; st[kt][1] = (f32x4){0.f, 0.f, 0.f, 0.f}; }
        {
            bf16x8 kfr[3][2];
#define FA_KLOAD(slot, jj) do { const int ks_ = (jj) >> 1, kh_ = (jj) & 1; _Pragma("unroll") for (int e = 0; e < 2; ++e) \
                kfr[slot][e] = *(const LAS bf16x8*)(kb + ((2 * kh_ + e) * 16 + i16) * 384 + (((ks_ * 4 + g4) ^ s7) * 16)); } while (0)
            FA_KLOAD(0, 0); FA_KLOAD(1, 1);
#pragma unroll
            for (int j = 0; j < 12; ++j) {
                const int ks = j >> 1, kh = j & 1;
                if (j + 2 < 12) FA_KLOAD((j + 2) % 3, j + 2);
                __builtin_amdgcn_sched_barrier(0);
#pragma unroll
                for (int e = 0; e < 2; ++e) { const int kt = 2 * kh + e; st[kt][0] = mfma16(kfr[j % 3][e], qf[0][ks], st[kt][0]); st[kt][1] = mfma16(kfr[j % 3][e], qf[1][ks], st[kt][1]); }
                __builtin_amdgcn_sched_barrier(0);
            }
#undef FA_KLOAD
        }
        bf16x8 pf[2][2];
#pragma unroll
        for (int qt = 0; qt < 2; ++qt) {
            float mx = -1e30f;
#pragma unroll
            for (int kt = 0; kt < 4; ++kt)
#pragma unroll
                for (int r = 0; r < 4; ++r) mx = fmaxf(mx, st[kt][qt][r]);
            mx = fmaxf(mx, shx(mx, 16, lane)); mx = fmaxf(mx, shx(mx, 32, lane));
            const float mn = fmaxf(mrun[qt], mx), alpha = ex2(mrun[qt] - mn); mrun[qt] = mn;
            float ps = 0.f;
#pragma unroll
            for (int kt = 0; kt < 4; ++kt)
#pragma unroll
                for (int r = 0; r < 4; ++r) { const float e = ex2(st[kt][qt][r] - mn); st[kt][qt][r] = e; ps += e; }
            lrun[qt] = lrun[qt] * alpha + ps;
            if (__builtin_amdgcn_ballot_w64(alpha != 1.0f) != 0ull) {
#pragma unroll
                for (int dt = 0; dt < 8; ++dt) o[dt][qt] *= alpha;
            }
            pf[qt][0] = pack8(st[0][qt], st[1][qt]); pf[qt][1] = pack8(st[2][qt], st[3][qt]);
        }
        const int vrow = 4 * g4 + qq, vsw = 2 * (vrow & 7);
        {
            bf16x8 vfr[3];
            const int cb = (pp & 1) * 8, ch0 = (pp >> 1);
#define FA_VLOAD(slot, jj) do { const int dt_ = (jj) >> 1, s2_ = (jj) & 1, ra_ = (2 * s2_) * 16 + vrow, co_ = (((dt_ * 2 + ch0) ^ vsw) * 16) + cb; \
                vfr[slot] = cat8(trread(vb + ra_ * 256 + co_), trread(vb + (ra_ + 16) * 256 + co_)); } while (0)
            FA_VLOAD(0, 0); FA_VLOAD(1, 1);
#pragma unroll
            for (int j = 0; j < 16; ++j) {
                const int dt = j >> 1, s2 = j & 1;
                if (j + 2 < 16) FA_VLOAD((j + 2) % 3, j + 2);
                __builtin_amdgcn_sched_barrier(0);
                o[dt][0] = mfma16(vfr[j % 3], pf[0][s2], o[dt][0]); o[dt][1] = mfma16(vfr[j % 3], pf[1][s2], o[dt][1]);
                __builtin_amdgcn_sched_barrier(0);
            }
#undef FA_VLOAD
        }
        asm volatile("s_waitcnt vmcnt(0)" ::: "memory");
        __syncthreads();
    }
#undef FA_STAGE
#pragma unroll
    for (int qt = 0; qt < 2; ++qt) {
        float lt = lrun[qt]; lt += shx(lt, 16, lane); lt += shx(lt, 32, lane);
        const float inv = 1.f / lt;
        const size_t tok = q0 + qt * 16 + i16;
        const bf16_t* Z = (const bf16_t*)(p->ws + WS_Z) + tok * 1792 + h * 128;
        bf16_t* OA = (bf16_t*)(p->ws + WS_OA) + tok * 512 + h * 128;
#pragma unroll
        for (int dt = 0; dt < 8; ++dt) {
            const int d = dt * 16 + 4 * g4; const u32x2 z = *(const u32x2*)(Z + d); const f32x4 c = o[dt][qt];
            u32x2 w; w.x = cvt_pk_bf16(c[0] * inv * bflo(z.x), c[1] * inv * bfhi(z.x)); w.y = cvt_pk_bf16(c[2] * inv * bflo(z.y), c[3] * inv * bfhi(z.y));
            *(u32x2*)(OA + d) = w;
        }
    }
}

#define XB_TMO      128
#define XB_XCNT(j)  (256  + 64 * (j))
#define XB_XSUB(j)  (1280 + 64 * (j))
#define XB_XGEN(j)  (2304 + 64 * (j))
#define XB_TOP      3328
#define XB_TOPGEN   3392
#define XCD_BAR_WORDS 3456
#define XB_SPIN_CAP (1u << 20)
DI unsigned xb_ld(unsigned* p) { return __hip_atomic_load(p, __ATOMIC_RELAXED, __HIP_MEMORY_SCOPE_AGENT); }
DI unsigned xb_add(unsigned* p, unsigned v) { return __hip_atomic_fetch_add(p, v, __ATOMIC_RELAXED, __HIP_MEMORY_SCOPE_AGENT); }
DI unsigned xb_xcc_id() { return (unsigned)__builtin_amdgcn_s_getreg((3 << 11) | 20) & 0xFu; }
#define XB_SPIN(cond, bar) do { unsigned _sp = 0; while (cond) { __builtin_amdgcn_s_sleep(1); \
    if ((++_sp & 255u) == 0u) { if (xb_ld(&(bar)[XB_TMO])) break; if (_sp > XB_SPIN_CAP) { atomicAdd(&(bar)[XB_TMO], 1u); break; } } } } while (0)
DI void xcd_barrier_complete(unsigned* bar, unsigned x, unsigned& nloc, unsigned& nx) {
    const unsigned G = gridDim.x;
    unsigned sum, cnt, mine, sp = 0u;
    for (;;) {
        sum = 0u; cnt = 0u; mine = 0u;
#pragma unroll
        for (unsigned j = 0; j < 16; ++j) { const unsigned c = xb_ld(&bar[XB_XCNT(j)]); sum += c; cnt += (c > 0u) ? 1u : 0u; mine = (j == x) ? c : mine; }
        if (sum == G) break;
        __builtin_amdgcn_s_sleep(1);
        if ((++sp & 255u) == 0u) { if (xb_ld(&bar[XB_TMO])) break; if (sp > XB_SPIN_CAP) { atomicAdd(&bar[XB_TMO], 1u); break; } }
    }
    nloc = mine > 0u ? mine : 1u; nx = cnt > 0u ? cnt : 1u;
}
DI void xcd_barrier(unsigned* bar, volatile LAS unsigned* st, int tid) {
    asm volatile("s_waitcnt vmcnt(0)" ::: "memory");
    __syncthreads();
    if (tid == 0) {
        __builtin_amdgcn_s_waitcnt(0);
        const unsigned x = xb_xcc_id();
        unsigned nloc = st[0], nx = st[1];
        if (nloc == 0u) { xcd_barrier_complete(bar, x, nloc, nx); st[0] = nloc; st[1] = nx; }
        const unsigned old = xb_add(&bar[XB_XSUB(x)], 1u);
        const unsigned gen = old / nloc;
        if (old + 1u == (gen + 1u) * nloc) {
            __builtin_amdgcn_fence(__ATOMIC_RELEASE, "agent");
            asm volatile("s_waitcnt vmcnt(0)" ::: "memory");
            const unsigned og = xb_add(&bar[XB_TOP], 1u);
            const unsigned tg = og / nx;
            if (og + 1u == (tg + 1u) * nx) xb_add(&bar[XB_TOPGEN], 1u);
            else XB_SPIN(xb_ld(&bar[XB_TOPGEN]) == tg, bar);
            __builtin_amdgcn_fence(__ATOMIC_ACQUIRE, "agent");
            xb_add(&bar[XB_XGEN(x)], 1u);
            asm volatile("s_waitcnt vmcnt(0)" ::: "memory");
        } else {
            XB_SPIN(xb_ld(&bar[XB_XGEN(x)]) == gen, bar);
            __builtin_amdgcn_fence(__ATOMIC_ACQUIRE, "agent");
            asm volatile("s_waitcnt vmcnt(0)" ::: "memory");
        }
    }
    __syncthreads();
}

__global__ void __launch_bounds__(512, 2) mega_fwd(Params pk) {
    extern __shared__ __attribute__((aligned(16))) unsigned char lds_raw[];
    LAS unsigned char* lds = (LAS unsigned char*)lds_raw;
    cg::grid_group grid = cg::this_grid();
    const int G = gridDim.x, c = blockIdx.x;
    const int wave_s = __builtin_amdgcn_readfirstlane((int)threadIdx.x >> 6);
    unsigned* bar = (unsigned*)(pk.ws + WS_BAR);
    volatile LAS unsigned* bst = (volatile LAS unsigned*)(lds + 131072);
    if (threadIdx.x < 2) bst[threadIdx.x] = 0u;
    if (blockIdx.x == 0) for (int i = threadIdx.x; i < XCD_BAR_WORDS; i += 512) __hip_atomic_store(bar + i, 0u, __ATOMIC_RELAXED, __HIP_MEMORY_SCOPE_AGENT);
    __syncthreads();
    for (int ph = pk.ph_lo; ph < pk.ph_hi; ++ph) {
        unsigned zero_ = 0u; asm volatile("" : "+s"(zero_));
        int tid = wave_s * 64 + (int)__builtin_amdgcn_mbcnt_hi(~0u, __builtin_amdgcn_mbcnt_lo(~0u, zero_)); asm volatile("" : "+v"(tid));
        if (ph > pk.ph_lo) {
            if (ph == pk.ph_lo + 1) {
                grid.sync();
                if (tid == 0) (void)xb_add(&bar[XB_XCNT(xb_xcc_id())], 1u);
            } else xcd_barrier(bar, bst, tid);
        }
        KP p = (KP)__builtin_amdgcn_kernarg_segment_ptr(); asm volatile("" : "+s"(p));
        unsigned char* ws = p->ws;
        const int lane = tid & 63, wave = __builtin_amdgcn_readfirstlane(tid >> 6);
#ifndef PHM
#define PHM 0xffff
#endif
#ifndef REPM
#define REPM 0
#endif
#ifndef REPN
#define REPN 2
#endif
#define NREP(bit) (((REPM) & (bit)) ? (REPN) : 1)
        if (ph == 0) { if (PHM & 1) phase_prep(p, lds, tid, wave, lane, G);
            phase_rms(p->in[0], p->in[1], (bf16_t*)(ws + WS_H), (float*)(ws + WS_SSQ), tid, wave, lane, G); continue; }
        if (ph == NPH - 1) { if (PHM & 2) phase_final(p->out, p->in[20], wave, lane, G); continue; }
        const int q = ph - 1, idx = q / 6, l = idx >> 1, gi = idx & 1, sp = q % 6 + 1;
        unsigned char* wb = ws + WS_W + l * W_LSTRIDE;
        const float* xin = (l == 0 ? p->in[0] : (const float*)p->out) + (size_t)gi * TG * DM;
        float* xout = p->out + (size_t)gi * TG * DM;
        if (sp == 0) {
        } else if (sp == 1) {
            pg8::SchedStd S; S.init(ws + WS_H, wb + W_1T, TG, 7168, 1024, G, c, NREP(8));
            EpiIn E{ws};
            if (PHM & 8) pg8::gemm_phase(lds, S, E, tid);
        } else if (sp == 2) {
            { pg8::SchedUp S{(const char*)ws, (const char*)wb, G, c, NREP(16)};
              EpiUp E{ws};
              if (PHM & 16) pg8::gemm_phase(lds, S, E, tid); }
            if (PHM & 32) for (int it = c; it < 1024 * NREP(32); it += G) gla_g1_item(lds, p, l, it & 1023, tid, wave, lane);
        } else if (sp == 3) {
            if (PHM & 64) dil_phase(lds, p, c, G, 1536 * NREP(64), tid, wave, lane);
            if (PHM & 128) nat_phase(lds, p, l, c, G, 1024 * NREP(128), tid, wave, lane);
            if (PHM & 256) gla_scan(p, G, tid);
        } else if (sp == 4) {
            if (PHM & 512) for (int u = c; u < 256 * NREP(512); u += G) mla_unit(lds, p, u & 255, tid, wave, lane);
            __syncthreads();
            if (PHM & 1024) for (int it = c; it < 1024 * NREP(1024); it += G) gla_g3_item(lds, p, l, it & 1023, tid, wave, lane);
            if (PHM & 2048) dil_merge(p, G, tid);
        } else if (sp == 5) {
            pg8::SchedMix S{(const char*)ws, (const char*)wb, G, c, NREP(4096)};
            EpiMix E{ws, p->in[18] + l * 4096};
            if (PHM & 4096) pg8::gemm_phase<EpiMix, pg8::SchedMix, MixState>(lds, S, E, tid);
        } else {
            pg8::SchedStd S; S.init(ws + WS_MIXED, wb + W_OUT, TG, 1024, 1024, G, c, NREP(8192));
            EpiOut E{xin, xout};
            if (PHM & 8192) pg8::gemm_phase(lds, S, E, tid);
            if (idx < 3) {
                const int nl = (idx + 1) >> 1, ng = (idx + 1) & 1;
                phase_rms((nl == 0 ? p->in[0] : (const float*)p->out) + (size_t)ng * TG * DM, p->in[1] + nl * DM, (bf16_t*)(ws + WS_H), (float*)(ws + WS_SSQ), tid, wave, lane, G);
            }
        }
    }
}

#ifndef MK_MULTI
#define MK_MULTI 0
#endif
extern "C" void kernel_launch(void* const* d_in, const int* in_sizes, int n_in, void* d_out, int out_size, void* d_ws, size_t ws_size, hipStream_t stream) {
    static int grid = 0;
    if (grid == 0) {
        if (n_in != 21 || ws_size < WS_END) { fprintf(stderr, "kernel_launch: unexpected n_in %d or ws_size %zu (< %zu)\n", n_in, ws_size, (size_t)WS_END); grid = -1; return; }
        int dev = 0, cus = 0, per_cu = 0;
        hipGetDevice(&dev);
        hipDeviceGetAttribute(&cus, hipDeviceAttributeMultiprocessorCount, dev);
        hipFuncSetAttribute((const void*)mega_fwd, hipFuncAttributeMaxDynamicSharedMemorySize, LDS_BYTES);
        hipOccupancyMaxActiveBlocksPerMultiprocessor(&per_cu, (const void*)mega_fwd, 512, LDS_BYTES);
        if (per_cu < 1) { fprintf(stderr, "kernel_launch: occupancy query returned %d\n", per_cu); per_cu = 1; }
        (void)hipGetLastError();
        grid = cus * per_cu;
        if (grid > 256) grid = 256;
    }
    if (grid < 0) return;
    Params p{};
    for (int i = 0; i < 21; ++i) p.in[i] = (const float*)d_in[i];
    p.out = (float*)d_out; p.ws = (unsigned char*)d_ws;
#if MK_MULTI
    for (int ph = 0; ph < NPH; ++ph) {
        p.ph_lo = ph; p.ph_hi = ph + 1;
        hipLaunchKernelGGL(mega_fwd, dim3(grid), dim3(512), LDS_BYTES, stream, p);
    }
#else
    p.ph_lo = 0; p.ph_hi = NPH;
    void* args[] = {&p};
    hipError_t e = hipLaunchCooperativeKernel((const void*)mega_fwd, dim3(grid), dim3(512), args, LDS_BYTES, stream);
    if (e != hipSuccess) fprintf(stderr, "cooperative launch failed: %s (grid %d)\n", hipGetErrorString(e), grid);
#endif
}
```
